# Optimizing an MI355X kernel written in HIP

```python
import math
import jax, jax.numpy as jnp
from jax import lax
import numpy as np

D_MODEL = 1024
BATCH = 8
SEQ = 2048
DEPTH = 4
DEC_BATCH = 128
DEC_SEQ = 4
PAST_LEN = 16384
PAGE_SIZE = 128

MIX_WIDTH = D_MODEL
A_HEADS = 4
A_WIDTH = MIX_WIDTH // 2
A_HEAD_DIM = A_WIDTH // A_HEADS
CHUNK_A = 128
B_HEADS = 4
B_WIDTH = MIX_WIDTH - A_WIDTH
B_HEAD_DIM = B_WIDTH // B_HEADS
DELTA_CHUNK = 64
CONV_W = 4
D_FF = 2816
PLE_DIM = 256
EPS = 1e-6
IN_WIDTH = 2 * A_WIDTH + 4 * B_WIDTH + 2 * B_HEADS

kernel_name = 'hybrid_gmlp_gdn_step'


def rmsnorm(x, gain):
    xf = x.astype(jnp.float32)
    y = xf * lax.rsqrt(jnp.mean(xf * xf, axis=-1, keepdims=True) + EPS)
    return (y * gain.astype(jnp.float32)).astype(x.dtype)


def l2norm(x):
    return x * lax.rsqrt(jnp.sum(x * x, axis=-1, keepdims=True) + EPS)


def swiglu(h, w_in, w_out):
    gate, up = jnp.split(h @ w_in, 2, axis=-1)
    return (jax.nn.silu(gate) * up) @ w_out


def chunk_gmlp(u, v, w_s, b_s):
    bsz, length = u.shape[:2]
    c = CHUNK_A if length % CHUNK_A == 0 else length
    n = length // c
    causal = jnp.tril(jnp.ones((c, c), dtype=bool))
    w = jnp.where(causal, w_s[:, :c, :c], 0.0).astype(v.dtype)
    vc = v.reshape(bsz, n, c, A_HEADS, A_HEAD_DIM)
    bias = jnp.transpose(b_s[:, :c])[:, :, None].astype(v.dtype)
    mixed = jnp.einsum('hts,bnshd->bnthd', w, vc) + bias
    return u * mixed.reshape(bsz, length, A_HEADS, A_HEAD_DIM)


def causal_conv_silu(x_pre, buf, w):
    length = x_pre.shape[1]
    xp = jnp.concatenate([buf.astype(x_pre.dtype), x_pre], axis=1)
    y = xp[:, 0:length] * w[0]
    for j in range(1, CONV_W):
        y = y + xp[:, j:j + length] * w[j]
    return jax.nn.silu(y), xp[:, xp.shape[1] - (CONV_W - 1):]


def gated_delta_rule(q, k, v, g, beta, s0):
    bsz, length, nh, dk = q.shape
    dv = v.shape[-1]
    c = DELTA_CHUNK if length % DELTA_CHUNK == 0 else length
    n = length // c

    def blocks(t):
        t = t.reshape((bsz, n, c, nh) + t.shape[3:])
        return jnp.moveaxis(t, 3, 1)

    q, k, v, g, beta = (blocks(t) for t in (q, k, v, g, beta))
    gam = jnp.cumsum(g, axis=-1)
    incl = jnp.tril(jnp.ones((c, c), dtype=bool))
    strict = jnp.tril(jnp.ones((c, c), dtype=bool), -1)
    diff = gam[..., :, None] - gam[..., None, :]
    decay = jnp.where(incl, jnp.exp(jnp.where(incl, diff, 0.0)), 0.0)
    kk = jnp.einsum('bhnci,bhnsi->bhncs', k, k)
    a_mat = jnp.eye(c, dtype=q.dtype) + jnp.where(strict, beta[..., :, None] * kk * decay, 0.0)

    def solve(rhs):
        return lax.linalg.triangular_solve(a_mat, rhs, left_side=True, lower=True, unit_diagonal=True)

    w_blk = solve(beta[..., None] * v)
    kb_blk = solve((beta * jnp.exp(gam))[..., None] * k)
    qk = jnp.einsum('bhnci,bhnsi->bhncs', q, k) * decay
    qb = q * jnp.exp(gam)[..., None]
    kend = k * jnp.exp(gam[..., -1:] - gam)[..., None]
    btot = jnp.exp(gam[..., -1])

    def step(s, blk):
        qb_n, qk_n, w_n, kb_n, kend_n, btot_n = blk
        u = w_n - jnp.einsum('bhci,bhij->bhcj', kb_n, s)
        o = jnp.einsum('bhci,bhij->bhcj', qb_n, s) + jnp.einsum('bhcs,bhsj->bhcj', qk_n, u)
        s = btot_n[..., None, None] * s + jnp.einsum('bhci,bhcj->bhij', kend_n, u)
        return s, o

    xs = tuple(jnp.moveaxis(t, 2, 0) for t in (qb, qk, w_blk, kb_blk, kend, btot))
    s_fin, o = lax.scan(step, s0, xs)
    o = jnp.transpose(o, (1, 0, 3, 2, 4)).reshape(bsz, length, nh, dv)
    return o, s_fin


def hybrid_layer(x, p, conv_buf, s0, lw):
    (n_f1, w_f1_in, w_f1_out, n_mix, w_in, a_v_gain, a_w_s, a_b_s, a_out_gain,
     b_conv, b_a_log, b_dt_bias, b_out_gain, w_out, n_f2, w_f2_in, w_f2_out,
     n_ple, w_ple_gate, w_ple_proj) = lw
    bsz, length, _ = x.shape
    f32 = jnp.float32
    x = x + 0.5 * swiglu(rmsnorm(x, n_f1), w_f1_in, w_f1_out)
    z = rmsnorm(x, n_mix) @ w_in
    uv = jax.nn.gelu(z[..., :2 * A_WIDTH])
    u = uv[..., :A_WIDTH].reshape(bsz, length, A_HEADS, A_HEAD_DIM)
    v = rmsnorm(uv[..., A_WIDTH:].reshape(bsz, length, A_HEADS, A_HEAD_DIM), a_v_gain)
    a_out = rmsnorm(chunk_gmlp(u, v, a_w_s, a_b_s), a_out_gain).reshape(bsz, length, A_WIDTH)
    o0 = 2 * A_WIDTH
    qkv, new_buf = causal_conv_silu(z[..., o0:o0 + 3 * B_WIDTH], conv_buf, b_conv)
    o1 = o0 + 3 * B_WIDTH
    a_logit = z[..., o1:o1 + B_HEADS]
    b_logit = z[..., o1 + B_HEADS:o1 + 2 * B_HEADS]
    gate = z[..., o1 + 2 * B_HEADS:]
    qkv = qkv.astype(f32).reshape(bsz, length, 3, B_HEADS, B_HEAD_DIM)
    q = l2norm(qkv[:, :, 0]) * (B_HEAD_DIM ** -0.5)
    k = l2norm(qkv[:, :, 1])
    vb = qkv[:, :, 2]
    g = -jnp.exp(b_a_log.astype(f32)) * jax.nn.softplus(a_logit.astype(f32) + b_dt_bias.astype(f32))
    beta = jax.nn.sigmoid(b_logit.astype(f32))
    o, s_new = gated_delta_rule(q, k, vb, g, beta, s0.astype(f32))
    o = rmsnorm(o, b_out_gain) * jax.nn.silu(gate.astype(f32).reshape(bsz, length, B_HEADS, B_HEAD_DIM))
    b_out = o.astype(x.dtype).reshape(bsz, length, B_WIDTH)
    x = x + jnp.concatenate([a_out, b_out], axis=-1) @ w_out
    x = x + 0.5 * swiglu(rmsnorm(x, n_f2), w_f2_in, w_f2_out)
    x = x + (p @ w_ple_proj) * jax.nn.sigmoid(rmsnorm(x, n_ple) @ w_ple_gate)
    return x, v, s_new.astype(s0.dtype), new_buf


def setup_inputs(seed: int = 0) -> dict:
    key = jax.random.key(seed)
    ks = jax.random.split(key, 32)

    def nrm(k, shape, scale):
        return jax.random.normal(k, shape, jnp.float32) * scale

    def gain(k, shape):
        return 1.0 + 0.01 * jax.random.normal(k, shape, jnp.float32)

    dt = jnp.exp(jax.random.uniform(ks[20], (DEPTH, B_HEADS), jnp.float32, math.log(1e-3), math.log(1e-1)))
    return {
        'x_prompt': nrm(ks[0], (BATCH, SEQ, D_MODEL), 1.0),
        'x_sample': nrm(ks[1], (DEC_BATCH, DEC_SEQ, D_MODEL), 1.0),
        'state_S': nrm(ks[2], (DEPTH, DEC_BATCH, B_HEADS, B_HEAD_DIM, B_HEAD_DIM), 0.05),
        'state_conv': nrm(ks[3], (DEPTH, DEC_BATCH, CONV_W - 1, 3 * B_WIDTH), 1.0),
        'p_prompt': nrm(ks[4], (DEPTH, BATCH, SEQ, PLE_DIM), 1.0),
        'p_sample': nrm(ks[5], (DEPTH, DEC_BATCH, DEC_SEQ, PLE_DIM), 1.0),
        'norm_ffn1': gain(ks[6], (DEPTH, D_MODEL)),
        'w_ffn1_in': nrm(ks[7], (DEPTH, D_MODEL, 2 * D_FF), D_MODEL ** -0.5),
        'w_ffn1_out': nrm(ks[8], (DEPTH, D_FF, D_MODEL), D_FF ** -0.5),
        'norm_mix': gain(ks[9], (DEPTH, D_MODEL)),
        'w_in': nrm(ks[10], (DEPTH, D_MODEL, IN_WIDTH), D_MODEL ** -0.5),
        'a_v_gain': gain(ks[11], (DEPTH, A_HEAD_DIM)),
        'a_spatial_w': nrm(ks[12], (DEPTH, A_HEADS, CHUNK_A, CHUNK_A), CHUNK_A ** -0.5),
        'a_spatial_b': 1.0 + nrm(ks[13], (DEPTH, A_HEADS, CHUNK_A), 0.1),
        'a_out_gain': gain(ks[14], (DEPTH, A_HEAD_DIM)),
        'b_conv_w': nrm(ks[15], (DEPTH, CONV_W, 3 * B_WIDTH), CONV_W ** -0.5),
        'b_a_log': jnp.log(jax.random.uniform(ks[16], (DEPTH, B_HEADS), jnp.float32, 1.0, 16.0)),
        'b_dt_bias': dt + jnp.log(-jnp.expm1(-dt)),
        'b_out_gain': gain(ks[17], (DEPTH, B_HEAD_DIM)),
        'w_out': nrm(ks[18], (DEPTH, MIX_WIDTH, D_MODEL), MIX_WIDTH ** -0.5),
        'norm_ffn2': gain(ks[19], (DEPTH, D_MODEL)),
        'w_ffn2_in': nrm(ks[21], (DEPTH, D_MODEL, 2 * D_FF), D_MODEL ** -0.5),
        'w_ffn2_out': nrm(ks[22], (DEPTH, D_FF, D_MODEL), D_FF ** -0.5),
        'norm_ple': gain(ks[23], (DEPTH, D_MODEL)),
        'w_ple_gate': nrm(ks[24], (DEPTH, D_MODEL, D_MODEL), D_MODEL ** -0.5),
        'w_ple_proj': nrm(ks[25], (DEPTH, PLE_DIM, D_MODEL), PLE_DIM ** -0.5),
        'final_norm': gain(ks[26], (D_MODEL,)),
    }


def reference(x_prompt, x_sample, state_S, state_conv, p_prompt, p_sample,
              norm_ffn1, w_ffn1_in, w_ffn1_out, norm_mix, w_in, a_v_gain, a_spatial_w,
              a_spatial_b, a_out_gain, b_conv_w, b_a_log, b_dt_bias, b_out_gain, w_out,
              norm_ffn2, w_ffn2_in, w_ffn2_out, norm_ple, w_ple_gate, w_ple_proj, final_norm):
    bsz = x_prompt.shape[0]
    zero_buf = jnp.zeros((bsz, CONV_W - 1, 3 * B_WIDTH), x_prompt.dtype)
    zero_s = jnp.zeros((bsz, B_HEADS, B_HEAD_DIM, B_HEAD_DIM), x_prompt.dtype)
    xp, xs = x_prompt, x_sample
    s_prompt, c_prompt, s_sample, c_sample, v_sample = [], [], [], [], []
    for i in range(DEPTH):
        lw = (norm_ffn1[i], w_ffn1_in[i], w_ffn1_out[i], norm_mix[i], w_in[i], a_v_gain[i],
              a_spatial_w[i], a_spatial_b[i], a_out_gain[i], b_conv_w[i], b_a_log[i], b_dt_bias[i],
              b_out_gain[i], w_out[i], norm_ffn2[i], w_ffn2_in[i], w_ffn2_out[i], norm_ple[i],
              w_ple_gate[i], w_ple_proj[i])
        xp, _, sp, cp = hybrid_layer(xp, p_prompt[i], zero_buf, zero_s, lw)
        xs, vs, ss, cs = hybrid_layer(xs, p_sample[i], state_conv[i], state_S[i], lw)
        s_prompt.append(sp)
        c_prompt.append(cp)
        s_sample.append(ss)
        c_sample.append(cs)
        v_sample.append(vs)
    y_prompt = rmsnorm(xp, final_norm)
    y_sample = rmsnorm(xs, final_norm)
    return (y_prompt, y_sample, jnp.stack(s_prompt), jnp.stack(c_prompt),
            jnp.stack(s_sample), jnp.stack(c_sample), jnp.stack(v_sample))
```

```cpp
#include <hip/hip_runtime.h>
#include <hip/hip_cooperative_groups.h>
#include <cstdio>
#include <cstdint>
namespace cg = cooperative_groups;

namespace pg8 {
#define PG8_LAS __attribute__((address_space(3)))
typedef unsigned short bf16_t;
typedef short bf16x8 __attribute__((ext_vector_type(8)));
typedef float f32x4 __attribute__((ext_vector_type(4)));
typedef unsigned u32x4 __attribute__((ext_vector_type(4)));
constexpr int BM = 256, BK = 64, HALF = 128, HTB = HALF * BK * 2  , STAGE_BYTES = 8 * HTB, NXCD = 8, WGM = 8;

__host__ __device__ __forceinline__ int lds_byte(int r, int c) { const int st = (r >> 4) * 2 + (c >> 5), rr = r & 15, cc = c & 31, ob = rr * 64 + cc * 2; return st * 1024 + (ob ^ (((ob >> 9) & 1) << 5)); }
__host__ __device__ __forceinline__ void stage_rc(int b, int& R, int& C) { const int st = b / 1024, sb = b % 1024, swz = sb ^ (((sb >> 9) & 1) << 5); R = (st >> 1) * 16 + swz / 64; C = (st & 1) * 32 + (swz % 64) / 2; }
__host__ __device__ __forceinline__ int perm32(int rho) { const int n = rho >> 4, i = rho & 15; return 8 * (i >> 2) + 4 * n + (i & 3); }

struct Unit { int pm, pn; };
struct Gemm { const bf16_t* A; const bf16_t* Bt; int M, N, K; };

struct StaticOrder {
    int nM, nN, nwg, G, c;
    __host__ __device__ void init(int M, int N, int G_, int c_) { nM = M / BM; nN = N / BM; nwg = nM * nN; G = G_; c = c_; }
    __host__ __device__ bool next(int i, Unit& u) const {
        const long L = (long)i * G + c; if (L >= nwg) return false;
        int wgid = (int)L; { const int q = nwg / NXCD, r = nwg % NXCD, xcd = wgid % NXCD, off = wgid / NXCD; wgid = (xcd < r ? xcd * (q + 1) : r * (q + 1) + (xcd - r) * q) + off; }
        const int nig = WGM * nN, gid = wgid / nig, fm = gid * WGM, gsz = (nM - fm) < WGM ? (nM - fm) : WGM;
        u.pm = fm + ((wgid % nig) % gsz); u.pn = (wgid % nig) / gsz; return true;
    }
    __device__ __forceinline__ void a_ready(const Unit&) const {}
    __device__ __forceinline__ void done(const Unit&) const {}
};
typedef __bf16 bf16x2_t __attribute__((ext_vector_type(2)));
typedef float f32x2_t __attribute__((ext_vector_type(2)));
__device__ __forceinline__ unsigned cvt_pk_bf16(float lo, float hi) { const f32x2_t f = {lo, hi}; const bf16x2_t v = __builtin_convertvector(f, bf16x2_t); return __builtin_bit_cast(unsigned, v); }
template <class Epi, class Sched, bool STAMP = false>
__device__ __forceinline__ void gemm_phase(PG8_LAS unsigned char* lds, const Gemm g, const Sched& S, const Epi& E, unsigned long long* stamps, const int tid) {
    const int wid = __builtin_amdgcn_readfirstlane(tid >> 6), lane = tid & 63, wr = wid >> 2, wc = wid & 3, fr = lane & 15, fq = lane >> 4;
    const int K = g.K, nt = K / BK;
    int ts_lo = 0, ts_hi = 0, nts = 0; const unsigned long long rt_entry = STAMP ? (unsigned long long)wall_clock64() : 0ull;
#define PG8_STAMP() do { if (STAMP && wid == 0 && nts < 64) { const unsigned long long _c = (unsigned long long)clock64(); \
        ts_lo = (lane == nts) ? (int)(unsigned)_c : ts_lo; ts_hi = (lane == nts) ? (int)(unsigned)(_c >> 32) : ts_hi; ++nts; } } while (0)
    PG8_STAMP();
    unsigned voffA[2], voffB[2];
#pragma unroll
    for (int i = 0; i < 2; ++i) { int R, C; stage_rc(tid * 16 + i * 8192, R, C); const int Rb = Epi::PERM ? ((R & ~31) + perm32(R & 31)) : R;
        voffA[i] = (unsigned)(R * K + C) * 2u; voffB[i] = (unsigned)(Rb * K + C) * 2u; }
    const size_t kstep = (size_t)(BK * 2);
    const size_t hstep = (size_t)HALF * K * 2;
    const size_t tstep = 2 * hstep;
    const unsigned ldsw = (unsigned)wid * 1024u;
    const int aoff = lds_byte(wr * 64 + fr, fq * 8), boff = lds_byte(wc * 32 + fr, fq * 8);
#define PG8_SA(b, h) (((b) * 2 + (h)) * HTB)
#define PG8_SB(b, h) ((4 + (b) * 2 + (h)) * HTB)
#define PG8_STAGE(bufoff, gbase, voff) do { _Pragma("unroll") for (int _i = 0; _i < 2; ++_i) \
        __builtin_amdgcn_global_load_lds((const unsigned*)((const char*)(gbase) + (voff)[_i]), (PG8_LAS unsigned*)(lds + (bufoff) + ldsw + _i * 8192), 16, 0, 0); } while (0)
#define PG8_LDA(dst, b, h) do { _Pragma("unroll") for (int m = 0; m < 4; ++m) _Pragma("unroll") for (int k = 0; k < 2; ++k) dst[m][k] = *(const PG8_LAS bf16x8*)(lds + PG8_SA(b, h) + aoff + m * 2048 + k * 1024); } while (0)
#define PG8_LDB(dst, b, h) do { _Pragma("unroll") for (int n = 0; n < 2; ++n) _Pragma("unroll") for (int k = 0; k < 2; ++k) dst[n][k] = *(const PG8_LAS bf16x8*)(lds + PG8_SB(b, h) + boff + n * 2048 + k * 1024); } while (0)
#define PG8_MMA(ai, bj, At, Bt) do { __builtin_amdgcn_s_setprio(1); _Pragma("unroll") for (int m = 0; m < 4; ++m) _Pragma("unroll") for (int n = 0; n < 2; ++n) _Pragma("unroll") for (int k = 0; k < 2; ++k) \
        acc[ai][bj][m][n] = __builtin_amdgcn_mfma_f32_16x16x32_bf16(Bt[n][k], At[m][k], acc[ai][bj][m][n], 0, 0, 0); __builtin_amdgcn_s_setprio(0); } while (0)
#define PG8_WAIT_V(n) asm volatile("s_waitcnt vmcnt(" #n ")" ::: "memory")
#define PG8_WAIT_L(n) asm volatile("s_waitcnt lgkmcnt(" #n ")" ::: "memory")
#define PG8_BAR __builtin_amdgcn_s_barrier()
#define PG8_SCHED __builtin_amdgcn_sched_barrier(0)
    Unit cur, nxt; int ui = 0;
    if (!S.next(0, cur)) return;
    f32x4 acc[2][2][4][2];
#pragma unroll
    for (int a = 0; a < 2; ++a)
#pragma unroll
        for (int b = 0; b < 2; ++b)
#pragma unroll
            for (int m = 0; m < 4; ++m)
#pragma unroll
                for (int n = 0; n < 2; ++n) acc[a][b][m][n] = (f32x4){0.f, 0.f, 0.f, 0.f};
    bf16x8 At[4][2], B0[2][2], B1[2][2];
    const char* cA = (const char*)g.A + (size_t)cur.pm * tstep; const char* cB = (const char*)g.Bt + (size_t)cur.pn * tstep;
    S.a_ready(cur);
    PG8_STAGE(PG8_SB(0, 0), cB, voffB); PG8_STAGE(PG8_SA(0, 0), cA, voffA); PG8_STAGE(PG8_SB(0, 1), cB + hstep, voffB); PG8_STAGE(PG8_SA(0, 1), cA + hstep, voffA);
    if (wr == 1) PG8_BAR;
    PG8_WAIT_V(4); PG8_BAR;
    PG8_STAGE(PG8_SB(1, 0), cB + kstep, voffB); PG8_STAGE(PG8_SA(1, 0), cA + kstep, voffA); PG8_STAGE(PG8_SB(1, 1), cB + hstep + kstep, voffB);
    PG8_WAIT_V(6); PG8_BAR;
    PG8_STAMP();
    for (;;) {
        const bool has_next = S.next(ui + 1, nxt);
        const char* nA = has_next ? (const char*)g.A + (size_t)nxt.pm * tstep : cA; const char* nB = has_next ? (const char*)g.Bt + (size_t)nxt.pn * tstep : cB;
        for (int t = 0; t < nt; t += 2) {
            const bool last = (t == nt - 2);
            const char* a1 = cA + (size_t)(t + 1) * kstep;
            const char* a2 = last ? nA : cA + (size_t)(t + 2) * kstep; const char* b2 = last ? nB : cB + (size_t)(t + 2) * kstep;
            const char* a3 = a2 + kstep; const char* b3 = b2 + kstep;
            if (last && has_next) S.a_ready(nxt);
            PG8_LDB(B0, 0, 0); PG8_SCHED; PG8_LDA(At, 0, 0); PG8_STAGE(PG8_SA(1, 1), a1 + hstep, voffA);
            PG8_WAIT_L(8); PG8_BAR; PG8_WAIT_L(0); PG8_MMA(0, 0, At, B0); PG8_BAR; PG8_SCHED;
            PG8_LDB(B1, 0, 1); PG8_STAGE(PG8_SB(0, 0), b2, voffB);
            PG8_BAR; PG8_WAIT_L(0); PG8_MMA(0, 1, At, B1); PG8_BAR;
            PG8_LDA(At, 0, 1); PG8_STAGE(PG8_SA(0, 0), a2, voffA);
            PG8_BAR; PG8_WAIT_L(0); PG8_MMA(1, 0, At, B0); PG8_BAR; PG8_SCHED;
            PG8_STAGE(PG8_SB(0, 1), b2 + hstep, voffB);
            PG8_WAIT_V(6); PG8_BAR; PG8_MMA(1, 1, At, B1); PG8_BAR;
            PG8_LDB(B0, 1, 0); PG8_SCHED; PG8_LDA(At, 1, 0); PG8_STAGE(PG8_SA(0, 1), a2 + hstep, voffA);
            PG8_WAIT_L(8); PG8_BAR; PG8_WAIT_L(0); PG8_MMA(0, 0, At, B0); PG8_BAR; PG8_SCHED;
            PG8_LDB(B1, 1, 1); PG8_STAGE(PG8_SB(1, 0), b3, voffB);
            PG8_BAR; PG8_WAIT_L(0); PG8_MMA(0, 1, At, B1); PG8_BAR;
            PG8_LDA(At, 1, 1); PG8_STAGE(PG8_SA(1, 0), a3, voffA);
            PG8_BAR; PG8_WAIT_L(0); PG8_MMA(1, 0, At, B0); PG8_BAR; PG8_SCHED;
            PG8_STAGE(PG8_SB(1, 1), b3 + hstep, voffB);
            PG8_WAIT_V(6); PG8_BAR; PG8_MMA(1, 1, At, B1); PG8_BAR;
        }
        PG8_STAMP();
        if constexpr (!Epi::AFTER_DRAIN) { E(acc, cur, wr, wc, fr, fq); S.done(cur); }
        PG8_STAMP();
        if (!has_next) break;
#pragma unroll
        for (int a = 0; a < 2; ++a)
#pragma unroll
            for (int b = 0; b < 2; ++b)
#pragma unroll
                for (int m = 0; m < 4; ++m)
#pragma unroll
                    for (int n = 0; n < 2; ++n) acc[a][b][m][n] = (f32x4){0.f, 0.f, 0.f, 0.f};
        cur = nxt; cA = nA; cB = nB; ++ui;
    }
    PG8_WAIT_V(0);
    if (wr == 0) PG8_BAR;
    PG8_BAR;
    if constexpr (Epi::AFTER_DRAIN) { E.fused(acc, cur, wr, wc, fr, fq, lds, wid, lane); S.done(cur); }
    PG8_STAMP();
    if (STAMP && wid == 0) { stamps[lane] = lane < nts ? (((unsigned long long)(unsigned)ts_hi << 32) | (unsigned)ts_lo) : 0ull;
        if (lane == 62) stamps[62] = rt_entry; if (lane == 63) stamps[63] = (unsigned long long)wall_clock64(); }
#undef PG8_STAMP
#undef PG8_SA
#undef PG8_SB
#undef PG8_STAGE
#undef PG8_LDA
#undef PG8_LDB
#undef PG8_MMA
#undef PG8_WAIT_V
#undef PG8_WAIT_L
#undef PG8_BAR
#undef PG8_SCHED
}
}

using pg8::bf16_t; using pg8::bf16x8; using pg8::f32x4; using pg8::u32x4; using pg8::cvt_pk_bf16;
typedef unsigned u32x2 __attribute__((ext_vector_type(2)));
typedef float f32x2v __attribute__((ext_vector_type(2)));
constexpr int TP = 16384, TS = 512, T = TP + TS, DM = 1024, DFF = 2816, NIN = 3328, ZG = 2560  , NPH_L = 16, NLAYER = 4;
constexpr float EPS = 1e-6f;
constexpr size_t W_F1IN = 0, W_F1OUT = W_F1IN + 5632ull * 1024, W_IN = W_F1OUT + 1024ull * 2816, W_OUT = W_IN + 3328ull * 1024, W_F2IN = W_OUT + 1024ull * 1024,
                 W_F2OUT = W_F2IN + 5632ull * 1024, W_GATE = W_F2OUT + 1024ull * 2816, W_PLE = W_GATE + 1024ull * 1024, W_TOTAL = W_PLE + 1024ull * 256;
constexpr size_t al256(size_t x) { return (x + 255) & ~(size_t)255; }
constexpr size_t WS_WT = 0, WS_XRES = al256(WS_WT + W_TOTAL * 2), WS_XN = al256(WS_XRES + (size_t)T * DM * 4), WS_PB = al256(WS_XN + (size_t)T * DM * 2), WS_MIX = al256(WS_PB + (size_t)T * 256 * 2),
                 WS_F = al256(WS_MIX + (size_t)T * DM * 2), WS_ZL = al256(WS_F + (size_t)T * NIN * 2), WS_UB = al256(WS_ZL + (size_t)T * 8 * 4), WS_VNB = al256(WS_UB + (size_t)T * 512 * 2),
                 WS_OBUF = al256(WS_VNB + (size_t)T * 512 * 2), WS_Q16 = al256(WS_OBUF + (size_t)T * 512 * 4), WS_K16 = al256(WS_Q16 + (size_t)T * 512 * 2), WS_V16 = al256(WS_K16 + (size_t)T * 512 * 2),
                 WS_GB = al256(WS_V16 + (size_t)T * 512 * 2), WS_BETA = al256(WS_GB + (size_t)T * 4 * 4), WS_BTOT = al256(WS_BETA + (size_t)T * 4 * 4), WS_CHUNK = al256(WS_BTOT + 1024 * 4),
                 CHUNK_BYTES = 90112, CK_WT = 0, CK_NKB = 32768, CK_QB = 49152, CK_KENDT = 65536, CK_QKD = 81920, WS_END = al256(WS_CHUNK + 1024 * CHUNK_BYTES);
constexpr size_t WS_PP = WS_CHUNK;
static_assert((size_t)T * DM * 4 <= 1024 * CHUNK_BYTES, "pp overlay");
constexpr size_t O_Y = 0, O_SP = (size_t)T * DM, O_CP = O_SP + 4ull * 8 * 4 * 128 * 128, O_SS = O_CP + 4ull * 8 * 3 * 1536, O_CS = O_SS + 4ull * 128 * 4 * 128 * 128, O_CV = O_CS + 4ull * 128 * 3 * 1536,
                 O_END = O_CV + 4ull * 128 * 4 * 4 * 128;
constexpr int LDS_BYTES = pg8::STAGE_BYTES;

struct Params { const float* in[27]; float* out; unsigned char* ws; int ph_lo, ph_hi; };
struct Ctx { int tid, bid, nb; };
enum { I_XP = 0, I_XS, I_SS, I_SC, I_PP, I_PS, I_NF1, I_WF1I, I_WF1O, I_NMIX, I_WIN, I_AVG, I_ASW, I_ASB, I_AOG, I_BCW, I_BAL, I_BDT, I_BOG, I_WOUT, I_NF2, I_WF2I, I_WF2O, I_NPLE, I_WPG, I_WPP, I_FN };

__device__ __forceinline__ float bf2f(unsigned short b) { return __uint_as_float(((unsigned)b) << 16); }
__device__ __forceinline__ float bflo(unsigned w) { return __uint_as_float(w << 16); }
__device__ __forceinline__ float bfhi(unsigned w) { return __uint_as_float(w & 0xffff0000u); }
__device__ __forceinline__ void unpack8(const u32x4 w, float (&f)[8]) { f[0] = bflo(w.x); f[1] = bfhi(w.x); f[2] = bflo(w.y); f[3] = bfhi(w.y); f[4] = bflo(w.z); f[5] = bfhi(w.z); f[6] = bflo(w.w); f[7] = bfhi(w.w); }
__device__ __forceinline__ u32x4 pack8(const float (&f)[8]) { u32x4 w; w.x = cvt_pk_bf16(f[0], f[1]); w.y = cvt_pk_bf16(f[2], f[3]); w.z = cvt_pk_bf16(f[4], f[5]); w.w = cvt_pk_bf16(f[6], f[7]); return w; }
__device__ __forceinline__ float sigmoidf_(float x) { return __builtin_amdgcn_rcpf(1.0f + __expf(-x)); }
__device__ __forceinline__ float siluf_(float x) { return x * sigmoidf_(x); }
__device__ __forceinline__ float gelu_tanh(float x) { const float u = 0.7978845608028654f * (x + 0.044715f * x * x * x); return x * sigmoidf_(2.0f * u); }
__device__ __forceinline__ float red16(float v) { v += __shfl_xor(v, 1); v += __shfl_xor(v, 2); v += __shfl_xor(v, 4); v += __shfl_xor(v, 8); return v; }
__device__ __forceinline__ float red64(float v) { v = red16(v); v += __shfl_xor(v, 16); v += __shfl_xor(v, 32); return v; }

struct EpiSwiGLU {
    static constexpr bool PERM = true, AFTER_DRAIN = false;
    bf16_t* H;
    __device__ __forceinline__ void operator()(const f32x4 (&acc)[2][2][4][2], const pg8::Unit& u, int wr, int wc, int fr, int fq) const {
        const int row0 = u.pm * 256 + wr * 64 + fr, col0 = u.pn * 128 + wc * 32 + 8 * fq;
#pragma unroll
        for (int ai = 0; ai < 2; ++ai)
#pragma unroll
            for (int m = 0; m < 4; ++m) {
                float o[8];
#pragma unroll
                for (int n = 0; n < 2; ++n)
#pragma unroll
                    for (int j = 0; j < 4; ++j) o[n * 4 + j] = siluf_(acc[ai][0][m][n][j]) * acc[ai][1][m][n][j];
                *(u32x4*)(H + (size_t)(row0 + ai * 128 + m * 16) * DFF + col0) = pack8(o);
            }
    }
};
struct EpiResid {
    static constexpr bool PERM = false, AFTER_DRAIN = false;
    float* X; float scale;
    __device__ __forceinline__ void operator()(const f32x4 (&acc)[2][2][4][2], const pg8::Unit& u, int wr, int wc, int fr, int fq) const {
        const int row0 = u.pm * 256 + wr * 64 + fr, col0 = u.pn * 256 + wc * 32 + 4 * fq;
#pragma unroll
        for (int ai = 0; ai < 2; ++ai)
#pragma unroll
            for (int m = 0; m < 4; ++m) { float* rowp = X + (size_t)(row0 + ai * 128 + m * 16) * DM + col0;
#pragma unroll
                for (int bj = 0; bj < 2; ++bj)
#pragma unroll
                    for (int n = 0; n < 2; ++n) { f32x4* q = (f32x4*)(rowp + bj * 128 + n * 16); *q = *q + acc[ai][bj][m][n] * scale; } }
    }
};
struct EpiZ {
    static constexpr bool PERM = true, AFTER_DRAIN = false;
    bf16_t* Z; float* ZL;
    __device__ __forceinline__ void operator()(const f32x4 (&acc)[2][2][4][2], const pg8::Unit& u, int wr, int wc, int fr, int fq) const {
        const int row0 = u.pm * 256 + wr * 64 + fr;
        if (u.pn == 12) {
            if (wc == 0 && fq == 0) {
#pragma unroll
                for (int ai = 0; ai < 2; ++ai)
#pragma unroll
                    for (int m = 0; m < 4; ++m) { float* q = ZL + (size_t)(row0 + ai * 128 + m * 16) * 8; *(f32x4*)q = acc[ai][0][m][0]; *(f32x4*)(q + 4) = acc[ai][0][m][1]; }
            }
            return;
        }
        const int col0 = u.pn * 256 + wc * 32 + 8 * fq;
#pragma unroll
        for (int ai = 0; ai < 2; ++ai)
#pragma unroll
            for (int m = 0; m < 4; ++m) { bf16_t* rowp = Z + (size_t)(row0 + ai * 128 + m * 16) * NIN + col0;
#pragma unroll
                for (int bj = 0; bj < 2; ++bj) { const f32x4 v0 = acc[ai][bj][m][0], v1 = acc[ai][bj][m][1];
                    u32x4 w; w.x = cvt_pk_bf16(v0[0], v0[1]); w.y = cvt_pk_bf16(v0[2], v0[3]); w.z = cvt_pk_bf16(v1[0], v1[1]); w.w = cvt_pk_bf16(v1[2], v1[3]);
                    *(u32x4*)(rowp + bj * 128) = w; } }
    }
};
struct EpiStoreF32 {
    static constexpr bool PERM = false, AFTER_DRAIN = false;
    float* C;
    __device__ __forceinline__ void operator()(const f32x4 (&acc)[2][2][4][2], const pg8::Unit& u, int wr, int wc, int fr, int fq) const {
        const int row0 = u.pm * 256 + wr * 64 + fr, col0 = u.pn * 256 + wc * 32 + 4 * fq;
#pragma unroll
        for (int ai = 0; ai < 2; ++ai)
#pragma unroll
            for (int m = 0; m < 4; ++m) { float* rowp = C + (size_t)(row0 + ai * 128 + m * 16) * DM + col0;
#pragma unroll
                for (int bj = 0; bj < 2; ++bj)
#pragma unroll
                    for (int n = 0; n < 2; ++n) *(f32x4*)(rowp + bj * 128 + n * 16) = acc[ai][bj][m][n]; }
    }
};
struct EpiPleGate {
    static constexpr bool PERM = false, AFTER_DRAIN = false;
    float* X; const float* PP;
    __device__ __forceinline__ void operator()(const f32x4 (&acc)[2][2][4][2], const pg8::Unit& u, int wr, int wc, int fr, int fq) const {
        const int row0 = u.pm * 256 + wr * 64 + fr, col0 = u.pn * 256 + wc * 32 + 4 * fq;
#pragma unroll
        for (int ai = 0; ai < 2; ++ai)
#pragma unroll
            for (int m = 0; m < 4; ++m) { const size_t ro = (size_t)(row0 + ai * 128 + m * 16) * DM + col0;
#pragma unroll
                for (int bj = 0; bj < 2; ++bj)
#pragma unroll
                    for (int n = 0; n < 2; ++n) { f32x4* q = (f32x4*)(X + ro + bj * 128 + n * 16); const f32x4 pp = *(const f32x4*)(PP + ro + bj * 128 + n * 16); const f32x4 a = acc[ai][bj][m][n];
                        f32x4 x = *q; x[0] += pp[0] * sigmoidf_(a[0]); x[1] += pp[1] * sigmoidf_(a[1]); x[2] += pp[2] * sigmoidf_(a[2]); x[3] += pp[3] * sigmoidf_(a[3]); *q = x; } }
    }
};
template <class Epi> __device__ __forceinline__ void run_gemm(PG8_LAS unsigned char* lds, const bf16_t* A, const bf16_t* Bt, int N, int K, const Epi& E, const Ctx& cx) {
    pg8::Gemm g; g.A = A; g.Bt = Bt; g.M = T; g.N = N; g.K = K;
    pg8::StaticOrder S; S.init(T, N, cx.nb, cx.bid);
    pg8::gemm_phase<Epi, pg8::StaticOrder, false>(lds, g, S, E, nullptr, cx.tid);
}

__device__ __forceinline__ int src_col(int map, int n) {
    if (map == 0) return n;
    if (map == 1) { const int pn = n >> 8, w = n & 255; return (w < 128) ? (pn * 128 + w) : (DFF + pn * 128 + (w - 128)); }
    if (n < 2560) return n;
    if (n < 3072) return n + 8;
    if (n < 3080) return 2560 + (n - 3072);
    return -1;
}
__device__ void phase_convert(const Params& p, int l, unsigned char* shm, const Ctx& cx) {
    float* tile = (float*)shm;
    bf16_t* wt = (bf16_t*)(p.ws + WS_WT);
    const int tid = cx.tid;
    for (int ti = cx.bid; ti < 5632; ti += cx.nb) {
        const float* src; int K, pitch, map, lt; bf16_t* dst;
        if (ti < 1408)      { lt = ti;        src = p.in[I_WF1I] + (size_t)l * 1024 * 5632; K = 1024; pitch = 5632; map = 1; dst = wt + W_F1IN; }
        else if (ti < 2112) { lt = ti - 1408; src = p.in[I_WF1O] + (size_t)l * 2816 * 1024; K = 2816; pitch = 1024; map = 0; dst = wt + W_F1OUT; }
        else if (ti < 2944) { lt = ti - 2112; src = p.in[I_WIN] + (size_t)l * 1024 * 3080;  K = 1024; pitch = 3080; map = 2; dst = wt + W_IN; }
        else if (ti < 3200) { lt = ti - 2944; src = p.in[I_WOUT] + (size_t)l * 1024 * 1024; K = 1024; pitch = 1024; map = 0; dst = wt + W_OUT; }
        else if (ti < 4608) { lt = ti - 3200; src = p.in[I_WF2I] + (size_t)l * 1024 * 5632; K = 1024; pitch = 5632; map = 1; dst = wt + W_F2IN; }
        else if (ti < 5312) { lt = ti - 4608; src = p.in[I_WF2O] + (size_t)l * 2816 * 1024; K = 2816; pitch = 1024; map = 0; dst = wt + W_F2OUT; }
        else if (ti < 5568) { lt = ti - 5312; src = p.in[I_WPG] + (size_t)l * 1024 * 1024;  K = 1024; pitch = 1024; map = 0; dst = wt + W_GATE; }
        else                { lt = ti - 5568; src = p.in[I_WPP] + (size_t)l * 256 * 1024;   K = 256;  pitch = 1024; map = 0; dst = wt + W_PLE; }
        const int nkt = K >> 6, nt_ = lt / nkt, kt = lt - nt_ * nkt, n0 = nt_ * 64, k0 = kt * 64;
        {
            const int r = tid >> 4, c4 = (tid & 15) * 4, sc = src_col(map, n0 + c4);
#pragma unroll
            for (int rr = 0; rr < 64; rr += 32) {
                f32x4 v = (f32x4){0.f, 0.f, 0.f, 0.f};
                if (sc >= 0) v = *(const f32x4*)(src + (size_t)(k0 + r + rr) * pitch + sc);
                float* tp = tile + (r + rr) * 65 + c4; tp[0] = v[0]; tp[1] = v[1]; tp[2] = v[2]; tp[3] = v[3];
            }
        }
        __syncthreads();
        {
            const int n = tid >> 3, kq = (tid & 7) * 8; float f[8];
#pragma unroll
            for (int e = 0; e < 8; ++e) f[e] = tile[(kq + e) * 65 + n];
            *(u32x4*)(dst + (size_t)(n0 + n) * K + k0 + kq) = pack8(f);
        }
        __syncthreads();
    }
    bf16_t* pb = (bf16_t*)(p.ws + WS_PB);
    for (int i = cx.bid * 512 + tid; i < T * 32; i += cx.nb * 512) {
        const int row = i >> 5, c8 = (i & 31) * 8;
        const float* s = (row < TP) ? p.in[I_PP] + ((size_t)l * TP + row) * 256 + c8 : p.in[I_PS] + ((size_t)l * TS + (row - TP)) * 256 + c8;
        const f32x4 a = *(const f32x4*)s, b = *(const f32x4*)(s + 4);
        u32x4 w; w.x = cvt_pk_bf16(a[0], a[1]); w.y = cvt_pk_bf16(a[2], a[3]); w.z = cvt_pk_bf16(b[0], b[1]); w.w = cvt_pk_bf16(b[2], b[3]);
        *(u32x4*)(pb + (size_t)row * 256 + c8) = w;
    }
}

__device__ void phase_norm(const Params& p, const float* gain, bool first, bool final_, const Ctx& cx) {
    const int tid = cx.tid, wid = tid >> 6, lane = tid & 63;
    float* xres = (float*)(p.ws + WS_XRES); bf16_t* xn = (bf16_t*)(p.ws + WS_XN);
    f32x4 g[4];
#pragma unroll
    for (int i = 0; i < 4; ++i) g[i] = *(const f32x4*)(gain + i * 256 + lane * 4);
    for (int row = cx.bid * 8 + wid; row < T; row += cx.nb * 8) {
        const float* s = first ? ((row < TP) ? p.in[I_XP] + (size_t)row * DM : p.in[I_XS] + (size_t)(row - TP) * DM) : xres + (size_t)row * DM;
        f32x4 v[4]; float ss = 0.f;
#pragma unroll
        for (int i = 0; i < 4; ++i) { v[i] = *(const f32x4*)(s + i * 256 + lane * 4); ss += v[i][0] * v[i][0] + v[i][1] * v[i][1] + v[i][2] * v[i][2] + v[i][3] * v[i][3]; }
        ss = red64(ss);
        const float r = rsqrtf(ss * (1.0f / 1024.0f) + EPS);
#pragma unroll
        for (int i = 0; i < 4; ++i) {
            const f32x4 y = v[i] * r * g[i];
            if (first) *(f32x4*)(xres + (size_t)row * DM + i * 256 + lane * 4) = v[i];
            if (final_) *(f32x4*)(p.out + O_Y + (size_t)row * DM + i * 256 + lane * 4) = y;
            else { u32x2 w; w.x = cvt_pk_bf16(y[0], y[1]); w.y = cvt_pk_bf16(y[2], y[3]); *(u32x2*)(xn + (size_t)row * DM + i * 256 + lane * 4) = w; }
        }
    }
}

__device__ void phase_postin(const Params& p, int l, const Ctx& cx) {
    const int tid = cx.tid, wid = tid >> 6, lane = tid & 63, c0 = lane * 8, hd = lane >> 4, cd = c0 & 127;
    const bf16_t* z = (const bf16_t*)(p.ws + WS_F); const float* zl = (const float*)(p.ws + WS_ZL);
    bf16_t* ub = (bf16_t*)(p.ws + WS_UB); bf16_t* vnb = (bf16_t*)(p.ws + WS_VNB);
    bf16_t* q16 = (bf16_t*)(p.ws + WS_Q16); bf16_t* k16 = (bf16_t*)(p.ws + WS_K16); bf16_t* v16 = (bf16_t*)(p.ws + WS_V16);
    float* gb = (float*)(p.ws + WS_GB); float* betab = (float*)(p.ws + WS_BETA);
    const float* avg = p.in[I_AVG] + l * 128; const float* cw = p.in[I_BCW] + (size_t)l * 4 * 1536;
    const float* sc = p.in[I_SC] + (size_t)l * 128 * 3 * 1536;
    float* cpo = p.out + O_CP + (size_t)l * 8 * 3 * 1536; float* cso = p.out + O_CS + (size_t)l * 128 * 3 * 1536; float* cvo = p.out + O_CV + (size_t)l * TS * 512;
    float gv[8];
#pragma unroll
    for (int e = 0; e < 8; ++e) gv[e] = avg[cd + e];
    for (int t = cx.bid * 8 + wid; t < T; t += cx.nb * 8) {
        const bool prompt = t < TP; const int b = prompt ? (t >> 11) : ((t - TP) >> 2), pos = prompt ? (t & 2047) : ((t - TP) & 3);
        const bf16_t* zr = z + (size_t)t * NIN;
        float f[8], o[8];
        unpack8(*(const u32x4*)(zr + c0), f);
#pragma unroll
        for (int e = 0; e < 8; ++e) o[e] = gelu_tanh(f[e]);
        *(u32x4*)(ub + (size_t)t * 512 + c0) = pack8(o);
        unpack8(*(const u32x4*)(zr + 512 + c0), f);
        float ss = 0.f;
#pragma unroll
        for (int e = 0; e < 8; ++e) { f[e] = gelu_tanh(f[e]); ss += f[e] * f[e]; }
        ss = red16(ss);
        { const float r = rsqrtf(ss * (1.0f / 128.0f) + EPS);
#pragma unroll
          for (int e = 0; e < 8; ++e) o[e] = f[e] * r * gv[e]; }
        *(u32x4*)(vnb + (size_t)t * 512 + c0) = pack8(o);
        if (!prompt) { float* q = cvo + (size_t)(t - TP) * 512 + c0; *(f32x4*)q = (f32x4){o[0], o[1], o[2], o[3]}; *(f32x4*)(q + 4) = (f32x4){o[4], o[5], o[6], o[7]}; }
#pragma unroll
        for (int grp = 0; grp < 3; ++grp) {
            const int ch = grp * 512 + c0;
            float y[8];
#pragma unroll
            for (int e = 0; e < 8; ++e) y[e] = 0.f;
#pragma unroll
            for (int j = 0; j < 4; ++j) {
                const int rp = pos - 3 + j;
                float pre[8];
                if (rp >= 0) unpack8(*(const u32x4*)(z + (size_t)(t - 3 + j) * NIN + 1024 + ch), pre);
                else if (!prompt) { const float* s = sc + ((size_t)b * 3 + (rp + 3)) * 1536 + ch; const f32x4 a = *(const f32x4*)s, bq = *(const f32x4*)(s + 4);
                    pre[0] = a[0]; pre[1] = a[1]; pre[2] = a[2]; pre[3] = a[3]; pre[4] = bq[0]; pre[5] = bq[1]; pre[6] = bq[2]; pre[7] = bq[3]; }
                else {
#pragma unroll
                    for (int e = 0; e < 8; ++e) pre[e] = 0.f; }
                const f32x4 w0 = *(const f32x4*)(cw + j * 1536 + ch), w1 = *(const f32x4*)(cw + j * 1536 + ch + 4);
                y[0] += pre[0] * w0[0]; y[1] += pre[1] * w0[1]; y[2] += pre[2] * w0[2]; y[3] += pre[3] * w0[3];
                y[4] += pre[4] * w1[0]; y[5] += pre[5] * w1[1]; y[6] += pre[6] * w1[2]; y[7] += pre[7] * w1[3];
                if (j == 3) {
                    float* dst = nullptr;
                    if (prompt) { if (pos >= 2045) dst = cpo + ((size_t)b * 3 + (pos - 2045)) * 1536 + ch; }
                    else if (pos >= 1) dst = cso + ((size_t)b * 3 + (pos - 1)) * 1536 + ch;
                    if (dst) { *(f32x4*)dst = (f32x4){pre[0], pre[1], pre[2], pre[3]}; *(f32x4*)(dst + 4) = (f32x4){pre[4], pre[5], pre[6], pre[7]}; }
                }
            }
            float s2 = 0.f;
#pragma unroll
            for (int e = 0; e < 8; ++e) { y[e] = siluf_(y[e]); s2 += y[e] * y[e]; }
            if (grp < 2) {
                s2 = red16(s2);
                const float r = rsqrtf(s2 + EPS) * (grp == 0 ? 0.08838834764831845f : 1.0f);
#pragma unroll
                for (int e = 0; e < 8; ++e) y[e] *= r;
            }
            bf16_t* dstb = (grp == 0 ? q16 : (grp == 1 ? k16 : v16)) + (size_t)t * 512 + c0;
            *(u32x4*)dstb = pack8(y);
        }
        if (lane < 4) {
            const float a = zl[(size_t)t * 8 + lane] + p.in[I_BDT][l * 4 + lane], bl = zl[(size_t)t * 8 + 4 + lane];
            const float sp = (a > 20.f) ? a : log1pf(__expf(a));
            gb[(size_t)t * 4 + lane] = -__expf(p.in[I_BAL][l * 4 + lane]) * sp;
            betab[(size_t)t * 4 + lane] = sigmoidf_(bl);
        }
    }
}

__device__ void phase_gmlp(const Params& p, int l, unsigned char* shm, const Ctx& cx) {
    const int tid = cx.tid, wid = tid >> 6, lane = tid & 63, fr = lane & 15, fq = lane >> 4;
    const bf16_t* ub = (const bf16_t*)(p.ws + WS_UB); const bf16_t* vnb = (const bf16_t*)(p.ws + WS_VNB); bf16_t* mix = (bf16_t*)(p.ws + WS_MIX);
    const float* aog = p.in[I_AOG] + l * 128;
    bf16_t* vs = (bf16_t*)shm;
    constexpr int VP = 136;
    for (int unit = cx.bid; unit < 512; unit += cx.nb) {
        const int b = unit >> 6, n = (unit >> 2) & 15, h = unit & 3, trow0 = b * 2048 + n * 128;
        const float* w = p.in[I_ASW] + ((size_t)l * 4 + h) * 128 * 128; const float* bias = p.in[I_ASB] + ((size_t)l * 4 + h) * 128;
#pragma unroll
        for (int ps = 0; ps < 4; ++ps) { const int r = ps * 32 + (tid >> 4), c8 = (tid & 15) * 8;
            *(u32x4*)(vs + r * VP + c8) = *(const u32x4*)(vnb + (size_t)(trow0 + r) * 512 + h * 128 + c8); }
        __syncthreads();
        const int t0 = wid * 16, tt = t0 + fr;
        f32x4 acc[8];
#pragma unroll
        for (int nb = 0; nb < 8; ++nb) acc[nb] = (f32x4){0.f, 0.f, 0.f, 0.f};
        for (int k0 = 0; k0 < t0 + 16; k0 += 32) {
            const float* wp = w + (size_t)tt * 128 + k0 + fq * 8;
            const f32x4 wa = *(const f32x4*)wp, wb = *(const f32x4*)(wp + 4);
            float wf[8] = {wa[0], wa[1], wa[2], wa[3], wb[0], wb[1], wb[2], wb[3]};
#pragma unroll
            for (int e = 0; e < 8; ++e) if (k0 + fq * 8 + e > tt) wf[e] = 0.f;
            const u32x4 wpk = pack8(wf); const bf16x8 wfrag = *(const bf16x8*)&wpk;
#pragma unroll
            for (int nb = 0; nb < 8; ++nb) {
                bf16x8 vf;
#pragma unroll
                for (int e = 0; e < 8; ++e) vf[e] = (short)vs[(k0 + fq * 8 + e) * VP + nb * 16 + fr];
                acc[nb] = __builtin_amdgcn_mfma_f32_16x16x32_bf16(vf, wfrag, acc[nb], 0, 0, 0);
            }
        }
        const int row = trow0 + tt; const float bs = bias[tt];
        float ss = 0.f;
#pragma unroll
        for (int nb = 0; nb < 8; ++nb) {
            const u32x2 uw = *(const u32x2*)(ub + (size_t)row * 512 + h * 128 + nb * 16 + fq * 4);
            acc[nb][0] = (acc[nb][0] + bs) * bflo(uw.x); acc[nb][1] = (acc[nb][1] + bs) * bfhi(uw.x); acc[nb][2] = (acc[nb][2] + bs) * bflo(uw.y); acc[nb][3] = (acc[nb][3] + bs) * bfhi(uw.y);
            ss += acc[nb][0] * acc[nb][0] + acc[nb][1] * acc[nb][1] + acc[nb][2] * acc[nb][2] + acc[nb][3] * acc[nb][3];
        }
        ss += __shfl_xor(ss, 16); ss += __shfl_xor(ss, 32);
        const float r = rsqrtf(ss * (1.0f / 128.0f) + EPS);
#pragma unroll
        for (int nb = 0; nb < 8; ++nb) {
            const f32x4 gg = *(const f32x4*)(aog + nb * 16 + fq * 4);
            u32x2 ow; ow.x = cvt_pk_bf16(acc[nb][0] * r * gg[0], acc[nb][1] * r * gg[1]); ow.y = cvt_pk_bf16(acc[nb][2] * r * gg[2], acc[nb][3] * r * gg[3]);
            *(u32x2*)(mix + (size_t)row * DM + h * 128 + nb * 16 + fq * 4) = ow;
        }
        __syncthreads();
    }
    {
        const int c0 = lane * 8, hd = lane >> 4, cd = c0 & 127;
        for (int st = cx.bid * 8 + wid; st < TS; st += cx.nb * 8) {
            const int b = st >> 2, t = st & 3; const float* w = p.in[I_ASW] + ((size_t)l * 4 + hd) * 128 * 128 + t * 128;
            float mx[8]; const float bs = p.in[I_ASB][((size_t)l * 4 + hd) * 128 + t];
#pragma unroll
            for (int e = 0; e < 8; ++e) mx[e] = bs;
            for (int s = 0; s <= t; ++s) { float f[8]; unpack8(*(const u32x4*)(vnb + (size_t)(TP + b * 4 + s) * 512 + c0), f); const float ws_ = w[s];
#pragma unroll
                for (int e = 0; e < 8; ++e) mx[e] += ws_ * f[e]; }
            float uf[8]; unpack8(*(const u32x4*)(ub + (size_t)(TP + st) * 512 + c0), uf);
            float ss = 0.f;
#pragma unroll
            for (int e = 0; e < 8; ++e) { mx[e] *= uf[e]; ss += mx[e] * mx[e]; }
            ss = red16(ss);
            const float r = rsqrtf(ss * (1.0f / 128.0f) + EPS);
#pragma unroll
            for (int e = 0; e < 8; ++e) mx[e] = mx[e] * r * aog[cd + e];
            *(u32x4*)(mix + (size_t)(TP + st) * DM + c0) = pack8(mx);
        }
    }
}

__device__ void phase_delta_pre(const Params& p, unsigned char* shm, const Ctx& cx) {
    const int tid = cx.tid, half = tid >> 8, lt = tid & 255, lw = lt >> 6, lane = tid & 63, fr = lane & 15, fq = lane >> 4;
    const bf16_t* q16 = (const bf16_t*)(p.ws + WS_Q16); const bf16_t* k16 = (const bf16_t*)(p.ws + WS_K16); const bf16_t* v16 = (const bf16_t*)(p.ws + WS_V16);
    const float* gb = (const float*)(p.ws + WS_GB); const float* betab = (const float*)(p.ws + WS_BETA); float* btot = (float*)(p.ws + WS_BTOT);
    float* Lm = (float*)(shm + half * 32768);
    float* gam = (float*)(shm + half * 32768 + 16384);
    float* bet = gam + 64;
    for (int it = cx.bid; it < 512; it += cx.nb) {
        const int ck = it * 2 + half, b = ck >> 7, h = (ck >> 5) & 3, n = ck & 31, t0 = b * 2048 + n * 64;
        unsigned char* cb = p.ws + WS_CHUNK + (size_t)ck * CHUNK_BYTES;
        if (lt < 64) {
            float g = gb[(size_t)(t0 + lt) * 4 + h];
#pragma unroll
            for (int d = 1; d < 64; d <<= 1) { const float o = __shfl_up(g, d); if (lane >= d) g += o; }
            gam[lt] = g; bet[lt] = betab[(size_t)(t0 + lt) * 4 + h];
            if (lt == 63) btot[ck] = __expf(g);
        }
        __syncthreads();
        {
            const int rb = lw; bf16x8 ak[4], aq[4];
#pragma unroll
            for (int ks = 0; ks < 4; ++ks) { const size_t o = (size_t)(t0 + rb * 16 + fr) * 512 + h * 128 + ks * 32 + fq * 8; ak[ks] = *(const bf16x8*)(k16 + o); aq[ks] = *(const bf16x8*)(q16 + o); }
            bf16_t* qkd = (bf16_t*)(cb + CK_QKD);
            for (int sb = 0; sb < 4; ++sb) {
                f32x4 ckk = (f32x4){0.f, 0.f, 0.f, 0.f}, cqk = (f32x4){0.f, 0.f, 0.f, 0.f};
                if (sb <= rb) {
#pragma unroll
                    for (int ks = 0; ks < 4; ++ks) { const bf16x8 bk = *(const bf16x8*)(k16 + (size_t)(t0 + sb * 16 + fr) * 512 + h * 128 + ks * 32 + fq * 8);
                        ckk = __builtin_amdgcn_mfma_f32_16x16x32_bf16(ak[ks], bk, ckk, 0, 0, 0); cqk = __builtin_amdgcn_mfma_f32_16x16x32_bf16(aq[ks], bk, cqk, 0, 0, 0); }
                }
                const int s = sb * 16 + fr; const float gs = gam[s];
#pragma unroll
                for (int r = 0; r < 4; ++r) { const int c = rb * 16 + fq * 4 + r; const float dec = (s <= c) ? __expf(gam[c] - gs) : 0.f;
                    Lm[c * 64 + s] = (s < c) ? bet[c] * ckk[r] * dec : 0.f;
                    qkd[c * 64 + s] = (bf16_t)(cvt_pk_bf16(cqk[r] * dec, 0.f) & 0xffffu); }
            }
        }
        __syncthreads();
        {
            const int j = lt & 127; const bool isk = lt >= 128;
            const bf16_t* srcc = (isk ? k16 : v16) + (size_t)t0 * 512 + h * 128 + j;
            float x[64];
#pragma unroll
            for (int c = 0; c < 64; ++c) x[c] = bf2f(srcc[(size_t)c * 512]);
            if (isk) {
                const float gl = gam[63]; bf16_t* kendT = (bf16_t*)(cb + CK_KENDT) + j * 64;
#pragma unroll
                for (int c8 = 0; c8 < 64; c8 += 8) { float f[8];
#pragma unroll
                    for (int e = 0; e < 8; ++e) f[e] = x[c8 + e] * __expf(gl - gam[c8 + e]);
                    *(u32x4*)(kendT + c8) = pack8(f); }
#pragma unroll
                for (int c = 0; c < 64; ++c) x[c] *= bet[c] * __expf(gam[c]);
            } else {
                bf16_t* qb = (bf16_t*)(cb + CK_QB);
#pragma unroll
                for (int c = 0; c < 64; ++c) { const float qv = bf2f(q16[(size_t)(t0 + c) * 512 + h * 128 + j]) * __expf(gam[c]); qb[c * 128 + j] = (bf16_t)(cvt_pk_bf16(qv, 0.f) & 0xffffu); }
#pragma unroll
                for (int c = 0; c < 64; ++c) x[c] *= bet[c];
            }
#pragma unroll
            for (int c = 1; c < 64; ++c) {
                float a = x[c];
#pragma unroll
                for (int s4 = 0; s4 < c; s4 += 4) { const f32x4 lv = *(const f32x4*)(Lm + c * 64 + s4);
                    a -= lv[0] * x[s4]; if (s4 + 1 < c) a -= lv[1] * x[s4 + 1]; if (s4 + 2 < c) a -= lv[2] * x[s4 + 2]; if (s4 + 3 < c) a -= lv[3] * x[s4 + 3]; }
                x[c] = a;
            }
            if (isk) { bf16_t* nkb = (bf16_t*)(cb + CK_NKB);
#pragma unroll
                for (int c = 0; c < 64; ++c) nkb[c * 128 + j] = (bf16_t)(cvt_pk_bf16(-x[c], 0.f) & 0xffffu);
            } else { float* wT = (float*)(cb + CK_WT) + j * 64;
#pragma unroll
                for (int c = 0; c < 64; c += 4) *(f32x4*)(wT + c) = (f32x4){x[c], x[c + 1], x[c + 2], x[c + 3]};
            }
        }
        __syncthreads();
    }
}

__device__ void phase_delta_scan(const Params& p, int l, unsigned char* shm, const Ctx& cx) {
    const int tid = cx.tid, wid = tid >> 6, lane = tid & 63, fr = lane & 15, fq = lane >> 4;
    float* obuf = (float*)(p.ws + WS_OBUF); const float* btot = (const float*)(p.ws + WS_BTOT);
    {
        float* kq = (float*)shm;
        float* red1 = kq + 1024;
        float* red2 = red1 + 512;
        const bf16_t* q16 = (const bf16_t*)(p.ws + WS_Q16); const bf16_t* k16 = (const bf16_t*)(p.ws + WS_K16); const bf16_t* v16 = (const bf16_t*)(p.ws + WS_V16);
        const float* gb = (const float*)(p.ws + WS_GB); const float* betab = (const float*)(p.ws + WS_BETA);
        const int j = tid & 127, iq = tid >> 7;
        for (int sq = cx.bid; sq < 512; sq += cx.nb) {
            const int b = sq >> 2, h = sq & 3;
            const float* s0 = p.in[I_SS] + (((size_t)l * 128 + b) * 4 + h) * 16384; float* so = p.out + O_SS + (((size_t)l * 128 + b) * 4 + h) * 16384;
            float S[32];
#pragma unroll
            for (int ii = 0; ii < 32; ++ii) S[ii] = s0[(size_t)(iq * 32 + ii) * 128 + j];
            { const int t = tid >> 7, jj = tid & 127; const size_t o = (size_t)(TP + b * 4 + t) * 512 + h * 128 + jj; kq[t * 256 + jj] = bf2f(k16[o]); kq[t * 256 + 128 + jj] = bf2f(q16[o]); }
            __syncthreads();
            for (int t = 0; t < 4; ++t) {
                const int row = TP + b * 4 + t; const float a = __expf(gb[(size_t)row * 4 + h]), bt = betab[(size_t)row * 4 + h];
                const float* kv = kq + t * 256 + iq * 32; const float* qv = kq + t * 256 + 128 + iq * 32;
                float part = 0.f;
#pragma unroll
                for (int ii = 0; ii < 32; ++ii) part += kv[ii] * S[ii];
                red1[iq * 128 + j] = part;
                __syncthreads();
                const float kS = red1[j] + red1[128 + j] + red1[256 + j] + red1[384 + j];
                const float d = bt * (bf2f(v16[(size_t)row * 512 + h * 128 + j]) - a * kS);
                float part2 = 0.f;
#pragma unroll
                for (int ii = 0; ii < 32; ++ii) { S[ii] = a * S[ii] + kv[ii] * d; part2 += qv[ii] * S[ii]; }
                red2[iq * 128 + j] = part2;
                __syncthreads();
                if (iq == 0) obuf[(size_t)row * 512 + h * 128 + j] = red2[j] + red2[128 + j] + red2[256 + j] + red2[384 + j];
            }
#pragma unroll
            for (int ii = 0; ii < 32; ++ii) so[(size_t)(iq * 32 + ii) * 128 + j] = S[ii];
            __syncthreads();
        }
    }
    {
        bf16_t* ST = (bf16_t*)shm;
        bf16_t* uT = (bf16_t*)(shm + 16 * 136 * 2);
        constexpr int SP = 136, UP = 72;
        for (int item = cx.bid; item < 256; item += cx.nb) {
            const int bh = item >> 3, b = bh >> 2, h = bh & 3, j0 = (item & 7) * 16;
            f32x4 accS = (f32x4){0.f, 0.f, 0.f, 0.f};
            const int i0 = wid * 16;
            __syncthreads();
            for (int i = tid; i < 16 * SP / 2; i += 512) ((unsigned*)ST)[i] = 0u;
            __syncthreads();
            for (int n = 0; n < 32; ++n) {
                const int ck = bh * 32 + n; const unsigned char* cb = p.ws + WS_CHUNK + (size_t)ck * CHUNK_BYTES;
                const int cbk = (wid & 3) * 16;
                f32x4 acc;
                if (wid < 4) {
                    acc = *(const f32x4*)((const float*)(cb + CK_WT) + (size_t)(j0 + fr) * 64 + cbk + fq * 4);
                    const bf16_t* A = (const bf16_t*)(cb + CK_NKB) + (size_t)(cbk + fr) * 128 + fq * 8;
#pragma unroll
                    for (int ks = 0; ks < 4; ++ks) { const bf16x8 a = *(const bf16x8*)(A + ks * 32); const bf16x8 bb = *(const bf16x8*)(ST + fr * SP + ks * 32 + fq * 8);
                        acc = __builtin_amdgcn_mfma_f32_16x16x32_bf16(a, bb, acc, 0, 0, 0); }
                    u32x2 w; w.x = cvt_pk_bf16(acc[0], acc[1]); w.y = cvt_pk_bf16(acc[2], acc[3]);
                    *(u32x2*)(uT + fr * UP + cbk + fq * 4) = w;
                } else {
                    acc = (f32x4){0.f, 0.f, 0.f, 0.f};
                    const bf16_t* A = (const bf16_t*)(cb + CK_QB) + (size_t)(cbk + fr) * 128 + fq * 8;
#pragma unroll
                    for (int ks = 0; ks < 4; ++ks) { const bf16x8 a = *(const bf16x8*)(A + ks * 32); const bf16x8 bb = *(const bf16x8*)(ST + fr * SP + ks * 32 + fq * 8);
                        acc = __builtin_amdgcn_mfma_f32_16x16x32_bf16(a, bb, acc, 0, 0, 0); }
                }
                __syncthreads();
                const bf16x8 u0 = *(const bf16x8*)(uT + fr * UP + fq * 8), u1 = *(const bf16x8*)(uT + fr * UP + 32 + fq * 8);
                if (wid >= 4) {
                    const bf16_t* A = (const bf16_t*)(cb + CK_QKD) + (size_t)(cbk + fr) * 64 + fq * 8;
                    acc = __builtin_amdgcn_mfma_f32_16x16x32_bf16(*(const bf16x8*)A, u0, acc, 0, 0, 0);
                    acc = __builtin_amdgcn_mfma_f32_16x16x32_bf16(*(const bf16x8*)(A + 32), u1, acc, 0, 0, 0);
                    float* op = obuf + (size_t)(b * 2048 + n * 64 + cbk + fq * 4) * 512 + h * 128 + j0 + fr;
                    op[0] = acc[0]; op[512] = acc[1]; op[1024] = acc[2]; op[1536] = acc[3];
                }
                {
                    const float bt = btot[ck];
                    accS = accS * bt;
                    const bf16_t* A = (const bf16_t*)(cb + CK_KENDT) + (size_t)(i0 + fr) * 64 + fq * 8;
                    accS = __builtin_amdgcn_mfma_f32_16x16x32_bf16(*(const bf16x8*)A, u0, accS, 0, 0, 0);
                    accS = __builtin_amdgcn_mfma_f32_16x16x32_bf16(*(const bf16x8*)(A + 32), u1, accS, 0, 0, 0);
                    u32x2 w; w.x = cvt_pk_bf16(accS[0], accS[1]); w.y = cvt_pk_bf16(accS[2], accS[3]);
                    *(u32x2*)(ST + fr * SP + i0 + fq * 4) = w;
                }
                __syncthreads();
            }
            float* so = p.out + O_SP + (((size_t)l * 8 + b) * 4 + h) * 16384 + (size_t)(i0 + fq * 4) * 128 + j0 + fr;
            so[0] = accS[0]; so[128] = accS[1]; so[256] = accS[2]; so[384] = accS[3];
        }
    }
}

__device__ void phase_bout(const Params& p, int l, const Ctx& cx) {
    const int tid = cx.tid, wid = tid >> 6, lane = tid & 63, c0 = lane * 8, cd = c0 & 127;
    const float* obuf = (const float*)(p.ws + WS_OBUF); const bf16_t* z = (const bf16_t*)(p.ws + WS_F); bf16_t* mix = (bf16_t*)(p.ws + WS_MIX);
    const float* bog = p.in[I_BOG] + l * 128;
    float gv[8];
#pragma unroll
    for (int e = 0; e < 8; ++e) gv[e] = bog[cd + e];
    for (int t = cx.bid * 8 + wid; t < T; t += cx.nb * 8) {
        const f32x4 a = *(const f32x4*)(obuf + (size_t)t * 512 + c0), bq = *(const f32x4*)(obuf + (size_t)t * 512 + c0 + 4);
        float o[8] = {a[0], a[1], a[2], a[3], bq[0], bq[1], bq[2], bq[3]}, gt[8];
        unpack8(*(const u32x4*)(z + (size_t)t * NIN + ZG + c0), gt);
        float ss = 0.f;
#pragma unroll
        for (int e = 0; e < 8; ++e) ss += o[e] * o[e];
        ss = red16(ss);
        const float r = rsqrtf(ss * (1.0f / 128.0f) + EPS);
#pragma unroll
        for (int e = 0; e < 8; ++e) o[e] = o[e] * r * gv[e] * siluf_(gt[e]);
        *(u32x4*)(mix + (size_t)t * DM + 512 + c0) = pack8(o);
    }
}

__device__ __forceinline__ void run_phase(const Params& p, int ph, unsigned char* shm, const Ctx& cx) {
    const int l = ph >> 4, s = ph & 15;
    PG8_LAS unsigned char* lds = (PG8_LAS unsigned char*)shm;
    const bf16_t* wt = (const bf16_t*)(p.ws + WS_WT);
    const bf16_t* xn = (const bf16_t*)(p.ws + WS_XN); bf16_t* hb = (bf16_t*)(p.ws + WS_F); float* xres = (float*)(p.ws + WS_XRES);
    switch (s) {
    case 0: phase_convert(p, l, shm, cx); if (l == 0) phase_norm(p, p.in[I_NF1], true, false, cx); break;
    case 1: { EpiSwiGLU E; E.H = hb; run_gemm(lds, xn, wt + W_F1IN, 5632, 1024, E, cx); } break;
    case 2: { EpiResid E; E.X = xres; E.scale = 0.5f; run_gemm(lds, hb, wt + W_F1OUT, 1024, 2816, E, cx); } break;
    case 3: phase_norm(p, p.in[I_NMIX] + l * 1024, false, false, cx); break;
    case 4: { EpiZ E; E.Z = hb; E.ZL = (float*)(p.ws + WS_ZL); run_gemm(lds, xn, wt + W_IN, NIN, 1024, E, cx); } break;
    case 5: phase_postin(p, l, cx); break;
    case 6: phase_gmlp(p, l, shm, cx); __syncthreads(); phase_delta_pre(p, shm, cx); break;
    case 7: phase_delta_scan(p, l, shm, cx); break;
    case 8: phase_bout(p, l, cx); break;
    case 9: { EpiResid E; E.X = xres; E.scale = 1.0f; run_gemm(lds, (const bf16_t*)(p.ws + WS_MIX), wt + W_OUT, 1024, 1024, E, cx); } break;
    case 10: phase_norm(p, p.in[I_NF2] + l * 1024, false, false, cx); break;
    case 11: { EpiSwiGLU E; E.H = hb; run_gemm(lds, xn, wt + W_F2IN, 5632, 1024, E, cx); } break;
    case 12: { EpiResid E; E.X = xres; E.scale = 0.5f; run_gemm(lds, hb, wt + W_F2OUT, 1024, 2816, E, cx); } break;
    case 13: { phase_norm(p, p.in[I_NPLE] + l * 1024, false, false, cx); __syncthreads();
               EpiStoreF32 E; E.C = (float*)(p.ws + WS_PP); run_gemm(lds, (const bf16_t*)(p.ws + WS_PB), wt + W_PLE, 1024, 256, E, cx); } break;
    case 14: { EpiPleGate E; E.X = xres; E.PP = (const float*)(p.ws + WS_PP); run_gemm(lds, xn, wt + W_GATE, 1024, 1024, E, cx); } break;
    default: if (l == NLAYER - 1) phase_norm(p, p.in[I_FN], false, true, cx); else phase_norm(p, p.in[I_NF1] + (l + 1) * 1024, false, false, cx); break;
    }
}

__global__ __launch_bounds__(512, 2) void mk_fwd(Params p) {
    extern __shared__ __attribute__((aligned(16))) unsigned char shm[];
    cg::grid_group grid = cg::this_grid();
    const int lo = p.ph_lo, hi = p.ph_hi;
    for (int ph = lo; ph < hi; ++ph) {
        if (ph > lo) grid.sync();
        const __attribute__((address_space(4))) Params* kp = (const __attribute__((address_space(4))) Params*)__builtin_amdgcn_kernarg_segment_ptr();
        asm volatile("" : "+s"(kp));
        Ctx cx; cx.tid = threadIdx.x; cx.bid = blockIdx.x; cx.nb = gridDim.x;
        asm volatile("" : "+v"(cx.tid)); asm volatile("" : "+s"(cx.bid), "+s"(cx.nb));
        run_phase(*(const Params*)kp, ph, shm, cx);
    }
}

#ifndef MK_DIAG
#define MK_DIAG 0
#endif
#if MK_DIAG
__device__ __forceinline__ unsigned hsh(unsigned x) { x ^= x >> 16; x *= 0x7feb352du; x ^= x >> 15; x *= 0x846ca68bu; x ^= x >> 16; return x; }
__device__ __forceinline__ bool bad(float got, float ref, float rel, float ab) { return !(fabsf(got - ref) <= rel * fabsf(ref) + ab); }
__global__ void diag_kernel(Params p, int ph) {
    unsigned* flags = (unsigned*)(p.ws + WS_END);
    const int i = threadIdx.x; const int l = 0;
    const bf16_t* wt = (const bf16_t*)(p.ws + WS_WT); const bf16_t* xn = (const bf16_t*)(p.ws + WS_XN); const bf16_t* F = (const bf16_t*)(p.ws + WS_F); const float* xres = (const float*)(p.ws + WS_XRES);
    if (ph == -1) { if (i == 0) flags[0] = 0u; return; }
    if (ph == 100) { if (i == 0) p.out[0] = exp2f((float)(flags[0] & 127u)); return; }
    bool f = false; int bit = -1;
    const bf16_t* q16 = (const bf16_t*)(p.ws + WS_Q16); const bf16_t* k16 = (const bf16_t*)(p.ws + WS_K16); const bf16_t* v16 = (const bf16_t*)(p.ws + WS_V16);
    const float* gb = (const float*)(p.ws + WS_GB); const float* betab = (const float*)(p.ws + WS_BETA); const float* obuf = (const float*)(p.ws + WS_OBUF);
    if (ph == 0) { bit = 6;
        { const int n = hsh(i) % 5632, k = hsh(i + 1000) % 1024; const int sc = src_col(1, n & ~3) + (n & 3); f |= bad(bf2f(wt[W_F2IN + (size_t)n * 1024 + k]), p.in[I_WF2I][(size_t)k * 5632 + sc], 0.01f, 1e-6f); }
        { const int n = hsh(i + 2) % 1024, k = hsh(i + 1002) % 2816; f |= bad(bf2f(wt[W_F2OUT + (size_t)n * 2816 + k]), p.in[I_WF2O][(size_t)k * 1024 + n], 0.01f, 1e-6f); }
        { const int n = hsh(i + 3) % 1024, k = hsh(i + 1003) % 1024; f |= bad(bf2f(wt[W_OUT + (size_t)n * 1024 + k]), p.in[I_WOUT][(size_t)k * 1024 + n], 0.01f, 1e-6f); }
        { const int n = hsh(i + 4) % 1024, k = hsh(i + 1004) % 1024; f |= bad(bf2f(wt[W_GATE + (size_t)n * 1024 + k]), p.in[I_WPG][(size_t)k * 1024 + n], 0.01f, 1e-6f); }
    }
    if (ph == 6) {
        const int ck = hsh(i / 64 + 900) % 1024, b = ck >> 7, h = (ck >> 5) & 3, n = ck & 31, t0 = b * 2048 + n * 64;
        const unsigned char* cb = p.ws + WS_CHUNK + (size_t)ck * CHUNK_BYTES;
        const int c = hsh(i + 31) % 64, j = hsh(i + 32) % 128, s_ = hsh(i + 33) % 64;
        float gamc = 0.f, gams = 0.f, gl = 0.f, run = 0.f;
        for (int t = 0; t < 64; ++t) { run += gb[(size_t)(t0 + t) * 4 + h]; if (t == c) gamc = run; if (t == s_) gams = run; if (t == 63) gl = run; }
        const float bc = betab[(size_t)(t0 + c) * 4 + h];
        float lw_ = 0.f, lk_ = 0.f, g2 = 0.f;
        const float* wT = (const float*)(cb + CK_WT) + (size_t)j * 64; const bf16_t* nkb = (const bf16_t*)(cb + CK_NKB);
        for (int s = 0; s < c; ++s) { g2 += gb[(size_t)(t0 + s) * 4 + h]; float kk = 0.f; for (int e = 0; e < 128; ++e) kk += bf2f(k16[(size_t)(t0 + c) * 512 + h * 128 + e]) * bf2f(k16[(size_t)(t0 + s) * 512 + h * 128 + e]);
            const float L = bc * kk * expf(gamc - g2); lw_ += L * wT[s]; lk_ += L * (-bf2f(nkb[s * 128 + j])); }
        const float rw = bc * bf2f(v16[(size_t)(t0 + c) * 512 + h * 128 + j]), rk = bc * expf(gamc) * bf2f(k16[(size_t)(t0 + c) * 512 + h * 128 + j]);
        if (bad(lw_ + wT[c], rw, 0.02f, 0.003f)) atomicOr(flags, 1u);
        if (bad(lk_ - bf2f(nkb[c * 128 + j]), rk, 0.03f, 0.002f)) atomicOr(flags, 2u);
        { float qk = 0.f; for (int e = 0; e < 128; ++e) qk += bf2f(q16[(size_t)(t0 + c) * 512 + h * 128 + e]) * bf2f(k16[(size_t)(t0 + s_) * 512 + h * 128 + e]);
          const float ref = (s_ <= c) ? qk * expf(gamc - gams) : 0.f; if (bad(bf2f(((const bf16_t*)(cb + CK_QKD))[c * 64 + s_]), ref, 0.03f, 0.0005f)) atomicOr(flags, 4u); }
        { bool g = false; g |= bad(bf2f(((const bf16_t*)(cb + CK_QB))[c * 128 + j]), bf2f(q16[(size_t)(t0 + c) * 512 + h * 128 + j]) * expf(gamc), 0.02f, 1e-5f);
          g |= bad(bf2f(((const bf16_t*)(cb + CK_KENDT))[j * 64 + c]), bf2f(k16[(size_t)(t0 + c) * 512 + h * 128 + j]) * expf(gl - gamc), 0.02f, 1e-5f);
          g |= bad(((const float*)(p.ws + WS_BTOT))[ck], expf(gl), 0.01f, 1e-30f); if (g) atomicOr(flags, 8u); }
    }
    if (ph == 7) {
        const int wv = i >> 6, lane = i & 63;
        {
            const int b = (wv * 3 + 1) & 7, h = wv & 3, j = (wv * 37 + 5) & 127;
            float s0 = 0.f, s1 = 0.f, maxerr = 0.f, maxref = 0.f; bool f4 = false;
            for (int t = 0; t < 2048; ++t) { const size_t r = (size_t)(b * 2048 + t); const float k0 = bf2f(k16[r * 512 + h * 128 + lane]), k1 = bf2f(k16[r * 512 + h * 128 + 64 + lane]);
                const float q0 = bf2f(q16[r * 512 + h * 128 + lane]), q1 = bf2f(q16[r * 512 + h * 128 + 64 + lane]); const float a = expf(gb[r * 4 + h]), bt = betab[r * 4 + h];
                const float kS = red64(k0 * s0 + k1 * s1); const float d = bt * (bf2f(v16[r * 512 + h * 128 + j]) - a * kS); s0 = a * s0 + k0 * d; s1 = a * s1 + k1 * d;
                const float o = red64(q0 * s0 + q1 * s1); maxerr = fmaxf(maxerr, fabsf(o - obuf[r * 512 + h * 128 + j])); maxref = fmaxf(maxref, fabsf(o));
                if (t == 63) f4 = !(maxerr <= 0.05f * maxref + 1e-4f); }
            if (f4) atomicOr(flags, 16u);
            if (!(maxerr <= 0.05f * maxref + 1e-4f)) atomicOr(flags, 32u);
        }
    }
    if (bit >= 0 && f) atomicOr(flags, 1u << bit);
}
#endif
#ifndef MK_ONE_LAUNCH
#define MK_ONE_LAUNCH 0
#endif
extern "C" void kernel_launch(void* const* d_in, const int* in_sizes, int n_in, void* d_out, int out_size, void* d_ws, size_t ws_size, hipStream_t stream) {
    static int grid = 0;
    if (grid == 0) {
        if (n_in != 27 || (size_t)out_size != O_END || ws_size < WS_END + 256) { fprintf(stderr, "kernel_launch: unexpected shapes (n_in %d out %d ws %zu need %zu)\n", n_in, out_size, ws_size, (size_t)WS_END); grid = -1; return; }
        int dev = 0, cus = 0, per_cu = 0;
        hipGetDevice(&dev); hipDeviceGetAttribute(&cus, hipDeviceAttributeMultiprocessorCount, dev);
        if (hipFuncSetAttribute((const void*)mk_fwd, hipFuncAttributeMaxDynamicSharedMemorySize, LDS_BYTES) != hipSuccess) { fprintf(stderr, "kernel_launch: hipFuncSetAttribute failed\n"); grid = -1; return; }
        if (hipOccupancyMaxActiveBlocksPerMultiprocessor(&per_cu, (const void*)mk_fwd, 512, LDS_BYTES) != hipSuccess || per_cu < 1) { fprintf(stderr, "kernel_launch: occupancy query says %d\n", per_cu); per_cu = 1; }
        (void)hipGetLastError();
        grid = cus * 1;
    }
    if (grid < 0) return;
    Params p{};
    for (int i = 0; i < 27; ++i) p.in[i] = (const float*)d_in[i];
    p.out = (float*)d_out; p.ws = (unsigned char*)d_ws;
#if MK_ONE_LAUNCH
    p.ph_lo = 0; p.ph_hi = NLAYER * NPH_L;
    void* args[] = {&p};
    hipError_t e = hipLaunchCooperativeKernel((const void*)mk_fwd, dim3(grid), dim3(512), args, LDS_BYTES, stream);
    if (e != hipSuccess) fprintf(stderr, "cooperative launch failed: %s (grid %d)\n", hipGetErrorString(e), grid);
#else
#if MK_DIAG
    hipLaunchKernelGGL(diag_kernel, dim3(1), dim3(256), 0, stream, p, -1);
#endif
    for (int ph = 0; ph < NLAYER * NPH_L; ++ph) { p.ph_lo = ph; p.ph_hi = ph + 1; hipLaunchKernelGGL(mk_fwd, dim3(grid), dim3(512), LDS_BYTES, stream, p);
#if MK_DIAG
        p.ph_lo = 0; p.ph_hi = 0; if (ph < 16) hipLaunchKernelGGL(diag_kernel, dim3(1), dim3(256), 0, stream, p, ph);
#endif
    }
#if MK_DIAG
    p.ph_lo = 0; p.ph_hi = 0; hipLaunchKernelGGL(diag_kernel, dim3(1), dim3(256), 0, stream, p, 100);
#endif
#endif
}
```

```cpp
#include <hip/hip_runtime.h>
#include <hip/hip_cooperative_groups.h>
#include <cstdio>
#include <cstdint>
namespace cg = cooperative_groups;
#ifndef MK_SP2
#define MK_SP2 true
#endif
#ifndef MK_ALIGN
#define MK_ALIGN true
#endif
#ifndef MK_TIME
#define MK_TIME 0
#endif

namespace pg8 {
#define PG8_LAS __attribute__((address_space(3)))
typedef unsigned short bf16_t;
typedef short bf16x8 __attribute__((ext_vector_type(8)));
typedef float f32x4 __attribute__((ext_vector_type(4)));
typedef unsigned u32x4 __attribute__((ext_vector_type(4)));
constexpr int BM = 256, BK = 64, HALF = 128, HTB = HALF * BK * 2  , STAGE_BYTES = 8 * HTB, NXCD = 8, WGM = 8;

__host__ __device__ __forceinline__ int lds_byte(int r, int c) { const int st = (r >> 4) * 2 + (c >> 5), rr = r & 15, cc = c & 31, ob = rr * 64 + cc * 2; return st * 1024 + (ob ^ (((ob >> 9) & 1) << 5)); }
__host__ __device__ __forceinline__ void stage_rc(int b, int& R, int& C) { const int st = b / 1024, sb = b % 1024, swz = sb ^ (((sb >> 9) & 1) << 5); R = (st >> 1) * 16 + swz / 64; C = (st & 1) * 32 + (swz % 64) / 2; }
__host__ __device__ __forceinline__ int perm32(int rho) { const int n = rho >> 4, i = rho & 15; return 8 * (i >> 2) + 4 * n + (i & 3); }

struct Unit { int pm, pn; };
struct Gemm { const bf16_t* A; const bf16_t* Bt; int M, N, K; };

struct StaticOrder {
    int nM, nN, nwg, G, c;
    __host__ __device__ void init(int M, int N, int G_, int c_) { nM = M / BM; nN = N / BM; nwg = nM * nN; G = G_; c = c_; }
    __host__ __device__ bool next(int i, Unit& u) const {
        const long L = (long)i * G + c; if (L >= nwg) return false;
        int wgid = (int)L; { const int q = nwg / NXCD, r = nwg % NXCD, xcd = wgid % NXCD, off = wgid / NXCD; wgid = (xcd < r ? xcd * (q + 1) : r * (q + 1) + (xcd - r) * q) + off; }
        const int nig = WGM * nN, gid = wgid / nig, fm = gid * WGM, gsz = (nM - fm) < WGM ? (nM - fm) : WGM;
        u.pm = fm + ((wgid % nig) % gsz); u.pn = (wgid % nig) / gsz; return true;
    }
    __device__ __forceinline__ void a_ready(const Unit&) const {}
    __device__ __forceinline__ void done(const Unit&) const {}
};
typedef __bf16 bf16x2_t __attribute__((ext_vector_type(2)));
typedef float f32x2_t __attribute__((ext_vector_type(2)));
__device__ __forceinline__ unsigned cvt_pk_bf16(float lo, float hi) { const f32x2_t f = {lo, hi}; const bf16x2_t v = __builtin_convertvector(f, bf16x2_t); return __builtin_bit_cast(unsigned, v); }
template <class Epi, class Sched, bool ALIGN_EPI = false, bool SP2 = false>
__device__ __forceinline__ void gemm_phase(PG8_LAS unsigned char* lds, const Gemm g, const Sched& S, const Epi& E, const int tid) {
    const int wid = __builtin_amdgcn_readfirstlane(tid >> 6), lane = tid & 63, wr = wid >> 2, wc = wid & 3, fr = lane & 15, fq = lane >> 4;
    const int K = g.K, nt = K / BK;
    unsigned voffA[2], voffB[2];
#pragma unroll
    for (int i = 0; i < 2; ++i) { int R, C; stage_rc(tid * 16 + i * 8192, R, C); const int Rb = Epi::PERM ? ((R & ~31) + perm32(R & 31)) : R;
        voffA[i] = (unsigned)(R * K + C) * 2u; voffB[i] = (unsigned)(Rb * K + C) * 2u; }
    const size_t kstep = (size_t)(BK * 2);
    const size_t hstep = (size_t)HALF * K * 2;
    const size_t tstep = 2 * hstep;
    const unsigned ldsw = (unsigned)wid * 1024u;
    const int aoff = lds_byte(wr * 64 + fr, fq * 8), boff = lds_byte(wc * 32 + fr, fq * 8);
#define PG8_SA(b, h) (((b) * 2 + (h)) * HTB)
#define PG8_SB(b, h) ((4 + (b) * 2 + (h)) * HTB)
#define PG8_STAGE(bufoff, gbase, voff) do { _Pragma("unroll") for (int _i = 0; _i < 2; ++_i) \
        __builtin_amdgcn_global_load_lds((const unsigned*)((const char*)(gbase) + (voff)[_i]), (PG8_LAS unsigned*)(lds + (bufoff) + ldsw + _i * 8192), 16, 0, 0); } while (0)
#define PG8_LDA(dst, b, h) do { _Pragma("unroll") for (int m = 0; m < 4; ++m) _Pragma("unroll") for (int k = 0; k < 2; ++k) dst[m][k] = *(const PG8_LAS bf16x8*)(lds + PG8_SA(b, h) + aoff + m * 2048 + k * 1024); } while (0)
#define PG8_LDB(dst, b, h) do { _Pragma("unroll") for (int n = 0; n < 2; ++n) _Pragma("unroll") for (int k = 0; k < 2; ++k) dst[n][k] = *(const PG8_LAS bf16x8*)(lds + PG8_SB(b, h) + boff + n * 2048 + k * 1024); } while (0)
#define PG8_MMA(ai, bj, At, Bt) do { __builtin_amdgcn_s_setprio(1); _Pragma("unroll") for (int m = 0; m < 4; ++m) _Pragma("unroll") for (int n = 0; n < 2; ++n) _Pragma("unroll") for (int k = 0; k < 2; ++k) \
        acc[ai][bj][m][n] = __builtin_amdgcn_mfma_f32_16x16x32_bf16(Bt[n][k], At[m][k], acc[ai][bj][m][n], 0, 0, 0); __builtin_amdgcn_s_setprio(0); } while (0)
#define PG8_WAIT_V(n) asm volatile("s_waitcnt vmcnt(" #n ")" ::: "memory")
#define PG8_WAIT_L(n) asm volatile("s_waitcnt lgkmcnt(" #n ")" ::: "memory")
#define PG8_BAR __builtin_amdgcn_s_barrier()
#define PG8_SCHED __builtin_amdgcn_sched_barrier(0)
    Unit cur, nxt; int ui = 0;
    if (!S.next(0, cur)) return;
    f32x4 acc[2][2][4][2];
#pragma unroll
    for (int a = 0; a < 2; ++a)
#pragma unroll
        for (int b = 0; b < 2; ++b)
#pragma unroll
            for (int m = 0; m < 4; ++m)
#pragma unroll
                for (int n = 0; n < 2; ++n) acc[a][b][m][n] = (f32x4){0.f, 0.f, 0.f, 0.f};
    bf16x8 At[4][2], B0[2][2], B1[2][2];
    const char* cA = (const char*)g.A + (size_t)cur.pm * tstep; const char* cB = (const char*)g.Bt + (size_t)cur.pn * tstep;
    S.a_ready(cur);
    if constexpr (SP2) {
        PG8_STAGE(PG8_SB(0, 0), cB, voffB); PG8_STAGE(PG8_SB(0, 1), cB + hstep, voffB); PG8_STAGE(PG8_SA(0, 0), cA, voffA); PG8_STAGE(PG8_SA(0, 1), cA + hstep, voffA);
        if (wr == 1) PG8_BAR;
        PG8_WAIT_V(2); PG8_BAR;
        PG8_STAGE(PG8_SB(1, 0), cB + kstep, voffB); PG8_STAGE(PG8_SA(1, 0), cA + kstep, voffA); PG8_STAGE(PG8_SB(1, 1), cB + hstep + kstep, voffB);
        PG8_WAIT_V(6); PG8_BAR;
    } else {
        PG8_STAGE(PG8_SB(0, 0), cB, voffB); PG8_STAGE(PG8_SA(0, 0), cA, voffA); PG8_STAGE(PG8_SB(0, 1), cB + hstep, voffB); PG8_STAGE(PG8_SA(0, 1), cA + hstep, voffA);
        if (wr == 1) PG8_BAR;
        PG8_WAIT_V(4); PG8_BAR;
        PG8_STAGE(PG8_SB(1, 0), cB + kstep, voffB); PG8_STAGE(PG8_SA(1, 0), cA + kstep, voffA); PG8_STAGE(PG8_SB(1, 1), cB + hstep + kstep, voffB);
        PG8_WAIT_V(6); PG8_BAR;
    }
    for (;;) {
        const bool has_next = S.next(ui + 1, nxt);
        const char* nA = has_next ? (const char*)g.A + (size_t)nxt.pm * tstep : cA; const char* nB = has_next ? (const char*)g.Bt + (size_t)nxt.pn * tstep : cB;
        for (int t = 0; t < nt; t += 2) {
            const bool last = (t == nt - 2);
            const char* a1 = cA + (size_t)(t + 1) * kstep;
            const char* a2 = last ? nA : cA + (size_t)(t + 2) * kstep; const char* b2 = last ? nB : cB + (size_t)(t + 2) * kstep;
            const char* a3 = a2 + kstep; const char* b3 = b2 + kstep;
            if (last && has_next) S.a_ready(nxt);
            if constexpr (SP2) {
            PG8_LDB(B0, 0, 0); PG8_LDB(B1, 0, 1); PG8_SCHED; PG8_LDA(At, 0, 0); PG8_STAGE(PG8_SA(1, 1), a1 + hstep, voffA);
            PG8_WAIT_V(8); PG8_WAIT_L(0); PG8_BAR; PG8_MMA(0, 0, At, B0); PG8_MMA(0, 1, At, B1); PG8_BAR; PG8_SCHED;
            PG8_LDA(At, 0, 1); PG8_STAGE(PG8_SB(0, 0), b2, voffB); PG8_STAGE(PG8_SB(0, 1), b2 + hstep, voffB); PG8_STAGE(PG8_SA(0, 0), a2, voffA);
            PG8_WAIT_V(8); PG8_WAIT_L(0); PG8_BAR; PG8_MMA(1, 0, At, B0); PG8_MMA(1, 1, At, B1); PG8_BAR; PG8_SCHED;
            PG8_LDB(B0, 1, 0); PG8_LDB(B1, 1, 1); PG8_SCHED; PG8_LDA(At, 1, 0); PG8_STAGE(PG8_SA(0, 1), a2 + hstep, voffA);
            PG8_WAIT_V(8); PG8_WAIT_L(0); PG8_BAR; PG8_MMA(0, 0, At, B0); PG8_MMA(0, 1, At, B1); PG8_BAR; PG8_SCHED;
            PG8_LDA(At, 1, 1); PG8_STAGE(PG8_SB(1, 0), b3, voffB); PG8_STAGE(PG8_SB(1, 1), b3 + hstep, voffB); PG8_STAGE(PG8_SA(1, 0), a3, voffA);
            PG8_WAIT_V(8); PG8_WAIT_L(0); PG8_BAR; PG8_MMA(1, 0, At, B0); PG8_MMA(1, 1, At, B1); PG8_BAR; PG8_SCHED;
            } else {
            PG8_LDB(B0, 0, 0); PG8_SCHED; PG8_LDA(At, 0, 0); PG8_STAGE(PG8_SA(1, 1), a1 + hstep, voffA);
            PG8_WAIT_L(8); PG8_BAR; PG8_WAIT_L(0); PG8_MMA(0, 0, At, B0); PG8_BAR; PG8_SCHED;
            PG8_LDB(B1, 0, 1); PG8_STAGE(PG8_SB(0, 0), b2, voffB);
            PG8_BAR; PG8_WAIT_L(0); PG8_MMA(0, 1, At, B1); PG8_BAR;
            PG8_LDA(At, 0, 1); PG8_STAGE(PG8_SA(0, 0), a2, voffA);
            PG8_BAR; PG8_WAIT_L(0); PG8_MMA(1, 0, At, B0); PG8_BAR; PG8_SCHED;
            PG8_STAGE(PG8_SB(0, 1), b2 + hstep, voffB);
            PG8_WAIT_V(6); PG8_BAR; PG8_MMA(1, 1, At, B1); PG8_BAR;
            PG8_LDB(B0, 1, 0); PG8_SCHED; PG8_LDA(At, 1, 0); PG8_STAGE(PG8_SA(0, 1), a2 + hstep, voffA);
            PG8_WAIT_L(8); PG8_BAR; PG8_WAIT_L(0); PG8_MMA(0, 0, At, B0); PG8_BAR; PG8_SCHED;
            PG8_LDB(B1, 1, 1); PG8_STAGE(PG8_SB(1, 0), b3, voffB);
            PG8_BAR; PG8_WAIT_L(0); PG8_MMA(0, 1, At, B1); PG8_BAR;
            PG8_LDA(At, 1, 1); PG8_STAGE(PG8_SA(1, 0), a3, voffA);
            PG8_BAR; PG8_WAIT_L(0); PG8_MMA(1, 0, At, B0); PG8_BAR; PG8_SCHED;
            PG8_STAGE(PG8_SB(1, 1), b3 + hstep, voffB);
            PG8_WAIT_V(6); PG8_BAR; PG8_MMA(1, 1, At, B1); PG8_BAR;
            }
        }
        if constexpr (ALIGN_EPI) { if (wr == 0) PG8_BAR; }
        if constexpr (!Epi::AFTER_DRAIN) { E(acc, cur, wr, wc, fr, fq); S.done(cur); }
        if (!has_next) break;
#pragma unroll
        for (int a = 0; a < 2; ++a)
#pragma unroll
            for (int b = 0; b < 2; ++b)
#pragma unroll
                for (int m = 0; m < 4; ++m)
#pragma unroll
                    for (int n = 0; n < 2; ++n) acc[a][b][m][n] = (f32x4){0.f, 0.f, 0.f, 0.f};
        cur = nxt; cA = nA; cB = nB; ++ui;
        if constexpr (ALIGN_EPI) { if (wr == 1) PG8_BAR; }
    }
    PG8_WAIT_V(0);
    if constexpr (!ALIGN_EPI) { if (wr == 0) PG8_BAR; }
    PG8_BAR;
    if constexpr (Epi::AFTER_DRAIN) { E.fused(acc, cur, wr, wc, fr, fq, lds, wid, lane); S.done(cur); }
#undef PG8_SA
#undef PG8_SB
#undef PG8_STAGE
#undef PG8_LDA
#undef PG8_LDB
#undef PG8_MMA
#undef PG8_WAIT_V
#undef PG8_WAIT_L
#undef PG8_BAR
#undef PG8_SCHED
}
}

#define XB_TMO      128
#define XB_XCNT(j)  (256  + 64 * (j))
#define XB_XSUB(j)  (1280 + 64 * (j))
#define XB_XGEN(j)  (2304 + 64 * (j))
#define XB_TOP      3328
#define XB_TOPGEN   3392
#define XCD_BAR_WORDS 3456
#define XB_SPIN_CAP (1u << 18)
#define LAS __attribute__((address_space(3)))

__device__ __forceinline__ unsigned xb_ld(unsigned* p)              { return __hip_atomic_load(p, __ATOMIC_RELAXED, __HIP_MEMORY_SCOPE_AGENT); }
__device__ __forceinline__ unsigned xb_add(unsigned* p, unsigned v) { return __hip_atomic_fetch_add(p, v, __ATOMIC_RELAXED, __HIP_MEMORY_SCOPE_AGENT); }
__device__ __forceinline__ unsigned xb_xcc_id() { return (unsigned)__builtin_amdgcn_s_getreg((3 << 11) | 20) & 0xFu; }
#define XB_SPIN(cond, bar) do { unsigned _sp = 0; while (cond) { __builtin_amdgcn_s_sleep(1); \
    if ((++_sp & 255u) == 0u) { if (xb_ld(&(bar)[XB_TMO])) break; if (_sp > XB_SPIN_CAP) { atomicAdd(&(bar)[XB_TMO], 1u); break; } } } } while (0)

struct XcdBarrier {
    unsigned* bar; unsigned x;
    volatile LAS unsigned* st;
};

__device__ __forceinline__ XcdBarrier xcd_barrier_post(unsigned* bar, volatile LAS unsigned* st) {
    XcdBarrier b; b.bar = bar; b.x = xb_xcc_id(); b.st = st;
    if (threadIdx.x == 0) (void)xb_add(&bar[XB_XCNT(b.x)], 1u);
    return b;
}
__device__ __forceinline__ void xcd_barrier_complete(unsigned* bar, unsigned x, unsigned& nloc, unsigned& nx) {
    const unsigned G = gridDim.x * gridDim.y * gridDim.z;
    unsigned sum, cnt, mine, sp = 0u;
    for (;;) {
        sum = 0u; cnt = 0u; mine = 0u;
#pragma unroll
        for (unsigned j = 0; j < 16; ++j) { const unsigned c = xb_ld(&bar[XB_XCNT(j)]); sum += c; cnt += (c > 0u) ? 1u : 0u; mine = (j == x) ? c : mine; }
        if (sum == G) break;
        __builtin_amdgcn_s_sleep(1);
        if ((++sp & 255u) == 0u) { if (xb_ld(&bar[XB_TMO])) break; if (sp > XB_SPIN_CAP) { atomicAdd(&bar[XB_TMO], 1u); break; } }
    }
    nloc = mine > 0u ? mine : 1u; nx = cnt > 0u ? cnt : 1u;
}

__device__ __forceinline__ void xcd_barrier(const XcdBarrier& b) {
    asm volatile("s_waitcnt vmcnt(0)" ::: "memory");
    __syncthreads();
    if (threadIdx.x == 0) {
        unsigned* bar = b.bar;
        __builtin_amdgcn_s_waitcnt(0);
        unsigned nloc = b.st[0], nx = b.st[1];
        if (nloc == 0u) { xcd_barrier_complete(bar, b.x, nloc, nx); b.st[0] = nloc; b.st[1] = nx; }
        const unsigned old = xb_add(&bar[XB_XSUB(b.x)], 1u);
        const unsigned gen = old / nloc;
        if (old + 1u == (gen + 1u) * nloc) {
            __builtin_amdgcn_fence(__ATOMIC_RELEASE, "agent");
            asm volatile("s_waitcnt vmcnt(0)" ::: "memory");
            const unsigned og = xb_add(&bar[XB_TOP], 1u);
            const unsigned tg = og / nx;
            if (og + 1u == (tg + 1u) * nx) xb_add(&bar[XB_TOPGEN], 1u);
            else XB_SPIN(xb_ld(&bar[XB_TOPGEN]) == tg, bar);
            __builtin_amdgcn_fence(__ATOMIC_ACQUIRE, "agent");
            xb_add(&bar[XB_XGEN(b.x)], 1u);
            asm volatile("s_waitcnt vmcnt(0)" ::: "memory");
        } else {
            XB_SPIN(xb_ld(&bar[XB_XGEN(b.x)]) == gen, bar);
            __builtin_amdgcn_fence(__ATOMIC_ACQUIRE, "agent");
            asm volatile("s_waitcnt vmcnt(0)" ::: "memory");
        }
    }
    __syncthreads();
}


using pg8::bf16_t; using pg8::bf16x8; using pg8::f32x4; using pg8::u32x4; using pg8::cvt_pk_bf16;
typedef unsigned u32x2 __attribute__((ext_vector_type(2)));
typedef float f32x2v __attribute__((ext_vector_type(2)));
constexpr int TP = 16384, TS = 512, T = TP + TS, DM = 1024, DFF = 2816, NIN = 3328, ZG = 2560  , NPH_L = 12, NLAYER = 4, NPHASES = NPH_L + (NPH_L - 1) * (NLAYER - 1) + 1;
constexpr float EPS = 1e-6f;
constexpr size_t W_F1IN = 0, W_F1OUT = W_F1IN + 5632ull * 1024, W_IN = W_F1OUT + 1024ull * 2816, W_OUT = W_IN + 3328ull * 1024, W_F2IN = W_OUT + 1024ull * 1024,
                 W_F2OUT = W_F2IN + 5632ull * 1024, W_GATE = W_F2OUT + 1024ull * 2816, W_PLE = W_GATE + 1024ull * 1024, W_TOTAL = W_PLE + 1024ull * 256;
constexpr size_t al256(size_t x) { return (x + 255) & ~(size_t)255; }
constexpr size_t WS_WT = 0  , WS_XN = al256(WS_WT + 2 * W_TOTAL * 2), WS_PB = al256(WS_XN + (size_t)T * DM * 2)  , WS_MIX = al256(WS_PB + 2 * (size_t)T * 256 * 2),
                 WS_F = al256(WS_MIX + (size_t)T * DM * 2), WS_ZL = al256(WS_F + (size_t)T * NIN * 2), WS_UB = al256(WS_ZL + (size_t)T * 8 * 4), WS_VNB = al256(WS_UB + (size_t)T * 512 * 2),
                 WS_OBUF = al256(WS_VNB + (size_t)T * 512 * 2), WS_Q16 = al256(WS_OBUF + (size_t)T * 512 * 4), WS_K16 = al256(WS_Q16 + (size_t)T * 512 * 2), WS_V16 = al256(WS_K16 + (size_t)T * 512 * 2),
                 WS_GB = al256(WS_V16 + (size_t)T * 512 * 2), WS_BETA = al256(WS_GB + (size_t)T * 4 * 4), WS_BTOT = al256(WS_BETA + (size_t)T * 4 * 4), WS_CHUNK = al256(WS_BTOT + 1024 * 4),
                 CHUNK_BYTES = 90112, CK_WT = 0, CK_NKB = 32768, CK_QB = 49152, CK_KENDT = 65536, CK_QKD = 81920, WS_ROWSS = al256(WS_CHUNK + 1024 * CHUNK_BYTES), WS_BAR = al256(WS_ROWSS + 16ull * T * 8), WS_STAMP = al256(WS_BAR + XCD_BAR_WORDS * 4), WS_END = al256(WS_STAMP + 4096);
constexpr size_t WS_PP = WS_CHUNK;
static_assert((size_t)T * DM * 4 <= 1024 * CHUNK_BYTES, "pp overlay");
constexpr size_t O_Y = 0, O_SP = (size_t)T * DM, O_CP = O_SP + 4ull * 8 * 4 * 128 * 128, O_SS = O_CP + 4ull * 8 * 3 * 1536, O_CS = O_SS + 4ull * 128 * 4 * 128 * 128, O_CV = O_CS + 4ull * 128 * 3 * 1536,
                 O_END = O_CV + 4ull * 128 * 4 * 4 * 128;
constexpr int LDS_BYTES = pg8::STAGE_BYTES + 16;

struct Params { const float* in[27]; float* out; unsigned char* ws; int ph_lo, ph_hi; };
struct Ctx { int tid, bid, nb; };
enum { I_XP = 0, I_XS, I_SS, I_SC, I_PP, I_PS, I_NF1, I_WF1I, I_WF1O, I_NMIX, I_WIN, I_AVG, I_ASW, I_ASB, I_AOG, I_BCW, I_BAL, I_BDT, I_BOG, I_WOUT, I_NF2, I_WF2I, I_WF2O, I_NPLE, I_WPG, I_WPP, I_FN };

__device__ __forceinline__ float bf2f(unsigned short b) { return __uint_as_float(((unsigned)b) << 16); }
__device__ __forceinline__ float bflo(unsigned w) { return __uint_as_float(w << 16); }
__device__ __forceinline__ float bfhi(unsigned w) { return __uint_as_float(w & 0xffff0000u); }
__device__ __forceinline__ void unpack8(const u32x4 w, float (&f)[8]) { f[0] = bflo(w.x); f[1] = bfhi(w.x); f[2] = bflo(w.y); f[3] = bfhi(w.y); f[4] = bflo(w.z); f[5] = bfhi(w.z); f[6] = bflo(w.w); f[7] = bfhi(w.w); }
__device__ __forceinline__ u32x4 pack8(const float (&f)[8]) { u32x4 w; w.x = cvt_pk_bf16(f[0], f[1]); w.y = cvt_pk_bf16(f[2], f[3]); w.z = cvt_pk_bf16(f[4], f[5]); w.w = cvt_pk_bf16(f[6], f[7]); return w; }
__device__ __forceinline__ float sigmoidf_(float x) { return __builtin_amdgcn_rcpf(1.0f + __expf(-x)); }
__device__ __forceinline__ float siluf_(float x) { return x * sigmoidf_(x); }
__device__ __forceinline__ float gelu_tanh(float x) { const float u = 0.7978845608028654f * (x + 0.044715f * x * x * x); return x * sigmoidf_(2.0f * u); }
__device__ __forceinline__ __amdgpu_buffer_rsrc_t wt_rsrc(void* base) { return __builtin_amdgcn_make_buffer_rsrc(base, 0, 0x7ffffff0, 0x00020000); }
__device__ __forceinline__ void st16_wt(const __amdgpu_buffer_rsrc_t r, size_t byte_off, u32x4 v) { __builtin_amdgcn_raw_buffer_store_b128(v, r, (unsigned)byte_off, 0,   16); }
__device__ __forceinline__ float red16(float v) { v += __shfl_xor(v, 1); v += __shfl_xor(v, 2); v += __shfl_xor(v, 4); v += __shfl_xor(v, 8); return v; }
__device__ __forceinline__ float red64(float v) { v = red16(v); v += __shfl_xor(v, 16); v += __shfl_xor(v, 32); return v; }

typedef unsigned long long u64;
constexpr float RS_FIX = 1048576.0f, RS_INV = 1.0f / (1048576.0f * 1024.0f);
__device__ __forceinline__ float rstd_of(u64 v) { return rsqrtf((float)(long long)v * RS_INV + EPS); }
__device__ __forceinline__ void load_rstd(const u64* RS, int row0, float (&rs)[2][4]) {
#pragma unroll
    for (int ai = 0; ai < 2; ++ai)
#pragma unroll
        for (int m = 0; m < 4; ++m) rs[ai][m] = rstd_of(RS[row0 + ai * 128 + m * 16]);
}
struct EpiSwiGLU {
    static constexpr bool PERM = true, AFTER_DRAIN = false, ALIGN = true;
    bf16_t* H; const u64* RS;
    __device__ __forceinline__ void operator()(const f32x4 (&acc)[2][2][4][2], const pg8::Unit& u, int wr, int wc, int fr, int fq) const {
        const int row0 = u.pm * 256 + wr * 64 + fr, col0 = u.pn * 128 + wc * 32 + 8 * fq;
        float rs[2][4]; load_rstd(RS, row0, rs);
        const __amdgpu_buffer_rsrc_t hr = wt_rsrc(H);
#pragma unroll
        for (int ai = 0; ai < 2; ++ai)
#pragma unroll
            for (int m = 0; m < 4; ++m) {
                float o[8];
#pragma unroll
                for (int n = 0; n < 2; ++n)
#pragma unroll
                    for (int j = 0; j < 4; ++j) o[n * 4 + j] = siluf_(acc[ai][0][m][n][j] * rs[ai][m]) * (acc[ai][1][m][n][j] * rs[ai][m]);
                st16_wt(hr, ((size_t)(row0 + ai * 128 + m * 16) * DFF + col0) * 2, pack8(o));
            }
    }
};
template <bool GATE> struct EpiResidT {
    static constexpr bool PERM = true, AFTER_DRAIN = false, ALIGN = false;
    static constexpr int MB = 4;
    const bf16_t* XS; bf16_t* XD; u64* RSO; float scale; const bf16_t* PP; const u64* RS;
    __device__ __forceinline__ void operator()(const f32x4 (&acc)[2][2][4][2], const pg8::Unit& u, int wr, int wc, int fr, int fq) const {
        const int row0 = u.pm * 256 + wr * 64 + fr, col0 = u.pn * 256 + wc * 32 + 8 * fq;
        const __amdgpu_buffer_rsrc_t xr = wt_rsrc(XD);
#pragma unroll
        for (int ai = 0; ai < 2; ++ai)
#pragma unroll
            for (int mh = 0; mh < 4; mh += MB) {
                u32x4 t[MB][2], pp[MB][2]; u64 rs[MB];
#pragma unroll
                for (int m = 0; m < MB; ++m) {
                    if (GATE) rs[m] = RS[row0 + ai * 128 + (mh + m) * 16];
#pragma unroll
                    for (int bj = 0; bj < 2; ++bj) { const size_t o = (size_t)(row0 + ai * 128 + (mh + m) * 16) * DM + col0 + bj * 128; t[m][bj] = __builtin_nontemporal_load((const u32x4*)(XS + o)); if (GATE) pp[m][bj] = __builtin_nontemporal_load((const u32x4*)(PP + o)); }
                }
#pragma unroll
                for (int m = 0; m < MB; ++m) {
                    const int row = row0 + ai * 128 + (mh + m) * 16; float ss = 0.f;
                    const float r = GATE ? rstd_of(rs[m]) : 0.f;
#pragma unroll
                    for (int bj = 0; bj < 2; ++bj) { const size_t o = (size_t)row * DM + col0 + bj * 128;
                        float x[8]; unpack8(t[m][bj], x);
                        if (GATE) { float q[8]; unpack8(pp[m][bj], q);
#pragma unroll
                            for (int e = 0; e < 8; ++e) x[e] += q[e] * sigmoidf_(acc[ai][bj][mh + m][e >> 2][e & 3] * r); }
                        else {
#pragma unroll
                            for (int e = 0; e < 8; ++e) x[e] += acc[ai][bj][mh + m][e >> 2][e & 3] * scale; }
                        const u32x4 w = pack8(x); st16_wt(xr, o * 2, w);
                        float y[8]; unpack8(w, y);
#pragma unroll
                        for (int e = 0; e < 8; ++e) ss += y[e] * y[e]; }
                    if (RSO) { ss += __shfl_xor(ss, 16); ss += __shfl_xor(ss, 32); if (fq == 0) atomicAdd(RSO + row, (u64)(long long)(ss * RS_FIX)); }
                }
            }
    }
};
struct EpiZ {
    static constexpr bool PERM = true, AFTER_DRAIN = false, ALIGN = true;
    bf16_t* Z; float* ZL; const u64* RS;
    __device__ __forceinline__ void operator()(const f32x4 (&acc)[2][2][4][2], const pg8::Unit& u, int wr, int wc, int fr, int fq) const {
        const int row0 = u.pm * 256 + wr * 64 + fr;
        float rs[2][4]; load_rstd(RS, row0, rs);
        if (u.pn == 12) {
            if (wc == 0 && fq == 0) {
#pragma unroll
                for (int ai = 0; ai < 2; ++ai)
#pragma unroll
                    for (int m = 0; m < 4; ++m) { float* q = ZL + (size_t)(row0 + ai * 128 + m * 16) * 8; *(f32x4*)q = acc[ai][0][m][0] * rs[ai][m]; *(f32x4*)(q + 4) = acc[ai][0][m][1] * rs[ai][m]; }
            }
            return;
        }
        const int col0 = u.pn * 256 + wc * 32 + 8 * fq; const __amdgpu_buffer_rsrc_t zr_ = wt_rsrc(Z);
#pragma unroll
        for (int ai = 0; ai < 2; ++ai)
#pragma unroll
            for (int m = 0; m < 4; ++m) { const size_t rowo = ((size_t)(row0 + ai * 128 + m * 16) * NIN + col0) * 2; const float r = rs[ai][m];
#pragma unroll
                for (int bj = 0; bj < 2; ++bj) { const f32x4 v0 = acc[ai][bj][m][0] * r, v1 = acc[ai][bj][m][1] * r;
                    u32x4 w; w.x = cvt_pk_bf16(v0[0], v0[1]); w.y = cvt_pk_bf16(v0[2], v0[3]); w.z = cvt_pk_bf16(v1[0], v1[1]); w.w = cvt_pk_bf16(v1[2], v1[3]);
                    st16_wt(zr_, rowo + bj * 256, w); } }
    }
};
struct EpiStoreBf16 {
    static constexpr bool PERM = true, AFTER_DRAIN = false, ALIGN = false;
    bf16_t* C;
    __device__ __forceinline__ void operator()(const f32x4 (&acc)[2][2][4][2], const pg8::Unit& u, int wr, int wc, int fr, int fq) const {
        const int row0 = u.pm * 256 + wr * 64 + fr, col0 = u.pn * 256 + wc * 32 + 8 * fq; const __amdgpu_buffer_rsrc_t cr = wt_rsrc(C);
#pragma unroll
        for (int ai = 0; ai < 2; ++ai)
#pragma unroll
            for (int m = 0; m < 4; ++m) { const size_t rowo = (size_t)(row0 + ai * 128 + m * 16) * DM + col0;
#pragma unroll
                for (int bj = 0; bj < 2; ++bj) { const f32x4 v0 = acc[ai][bj][m][0], v1 = acc[ai][bj][m][1];
                    u32x4 w; w.x = cvt_pk_bf16(v0[0], v0[1]); w.y = cvt_pk_bf16(v0[2], v0[3]); w.z = cvt_pk_bf16(v1[0], v1[1]); w.w = cvt_pk_bf16(v1[2], v1[3]);
                    st16_wt(cr, (rowo + bj * 128) * 2, w); } }
    }
};
template <class Epi> __device__ __forceinline__ void run_gemm(PG8_LAS unsigned char* lds, const bf16_t* A, const bf16_t* Bt, int N, int K, const Epi& E, const Ctx& cx, int M = T) {
    pg8::Gemm g; g.A = A; g.Bt = Bt; g.M = M; g.N = N; g.K = K;
    pg8::StaticOrder S; S.init(M, N, cx.nb, cx.bid);
    pg8::gemm_phase<Epi, pg8::StaticOrder, (MK_ALIGN && Epi::ALIGN), MK_SP2>(lds, g, S, E, cx.tid);
}

template <int MODE, class EP> __device__ __forceinline__ void mini_gemm_sample(const bf16_t* A, const bf16_t* Bt, int K, const EP& E, const Ctx& cx, unsigned char* shm) {
    const int tid = cx.tid, wv = __builtin_amdgcn_readfirstlane(tid >> 6), lane = tid & 63, fr = lane & 15, fq = lane >> 4;
    constexpr int STG = 96 * 256;
    const int ns = K >> 7;
    int srow[3], sdst[3]; bool sisA[3];
#pragma unroll
    for (int i = 0; i < 3; ++i) { const int g = tid + 512 * i, c = g & 15; sisA[i] = g < 512; srow[i] = sisA[i] ? (g >> 4) : ((g - 512) >> 4);
        sdst[i] = (sisA[i] ? 0 : 32 * 256) + srow[i] * 256 + ((c ^ (srow[i] & 15)) << 4); }
    const int cch = (tid & 15) * 8;
    for (int blk = cx.bid; blk < 256; blk += cx.nb) {
        const int rbase = TP + (blk >> 4) * 32, cbase = (blk & 15) * 64;
        const bf16_t* gsrc[3];
#pragma unroll
        for (int i = 0; i < 3; ++i) gsrc[i] = (sisA[i] ? A + (size_t)(rbase + srow[i]) * K : Bt + (size_t)(cbase + srow[i]) * K) + cch;
        u32x4 R0[3], R1[3];
#pragma unroll
        for (int i = 0; i < 3; ++i) { R0[i] = *(const u32x4*)(gsrc[i]); R1[i] = *(const u32x4*)(gsrc[i] + 128); }
        __syncthreads();
#pragma unroll
        for (int i = 0; i < 3; ++i) *(u32x4*)(shm + sdst[i]) = R0[i];
        __syncthreads();
        f32x4 acc0 = (f32x4){0.f, 0.f, 0.f, 0.f}, acc1 = acc0;
        const int arow = (wv >> 2) * 16 + fr, brow = (wv & 3) * 16 + fr;
        const int aoff = arow * 256, boff = 32 * 256 + brow * 256, asw = arow & 15, bsw = brow & 15;
#define MINI_COMPUTE(stage) do { const unsigned char* sb_ = shm + (stage) * STG; \
            _Pragma("unroll") for (int ks = 0; ks < 4; ks += 2) { \
                const bf16x8 a0_ = *(const bf16x8*)(sb_ + aoff + (((ks * 4 + fq) ^ asw) << 4)), b0_ = *(const bf16x8*)(sb_ + boff + (((ks * 4 + fq) ^ bsw) << 4)); \
                const bf16x8 a1_ = *(const bf16x8*)(sb_ + aoff + ((((ks + 1) * 4 + fq) ^ asw) << 4)), b1_ = *(const bf16x8*)(sb_ + boff + ((((ks + 1) * 4 + fq) ^ bsw) << 4)); \
                acc0 = __builtin_amdgcn_mfma_f32_16x16x32_bf16(b0_, a0_, acc0, 0, 0, 0); acc1 = __builtin_amdgcn_mfma_f32_16x16x32_bf16(b1_, a1_, acc1, 0, 0, 0); } } while (0)
        for (int sl = 0; sl < ns; sl += 2) {
            if (sl + 2 < ns) {
#pragma unroll
                for (int i = 0; i < 3; ++i) R0[i] = *(const u32x4*)(gsrc[i] + (size_t)(sl + 2) * 128); }
            MINI_COMPUTE(0);
#pragma unroll
            for (int i = 0; i < 3; ++i) *(u32x4*)(shm + STG + sdst[i]) = R1[i];
            __syncthreads();
            if (sl + 3 < ns) {
#pragma unroll
                for (int i = 0; i < 3; ++i) R1[i] = *(const u32x4*)(gsrc[i] + (size_t)(sl + 3) * 128); }
            MINI_COMPUTE(1);
            if (sl + 2 < ns) {
#pragma unroll
                for (int i = 0; i < 3; ++i) *(u32x4*)(shm + sdst[i]) = R0[i]; }
            __syncthreads();
        }
#undef MINI_COMPUTE
        const f32x4 a = acc0 + acc1;
        const int row0 = rbase + (wv >> 2) * 16, col0 = cbase + (wv & 3) * 16;
        const int row = row0 + fr; const size_t o = (size_t)row * DM + col0 + fq * 4;
        if constexpr (MODE == 2) { u32x2 w; w.x = cvt_pk_bf16(a[0], a[1]); w.y = cvt_pk_bf16(a[2], a[3]); *(u32x2*)(E.XD + o) = w; }
        else {
            const u32x2 tw = *(const u32x2*)(E.XS + o); f32x4 x = (f32x4){bflo(tw.x), bfhi(tw.x), bflo(tw.y), bfhi(tw.y)};
            if constexpr (MODE == 1) { const float r = rstd_of(E.RS[row]); const u32x2 qw = *(const u32x2*)(E.PP + o); const f32x4 q = (f32x4){bflo(qw.x), bfhi(qw.x), bflo(qw.y), bfhi(qw.y)};
                x[0] += q[0] * sigmoidf_(a[0] * r); x[1] += q[1] * sigmoidf_(a[1] * r); x[2] += q[2] * sigmoidf_(a[2] * r); x[3] += q[3] * sigmoidf_(a[3] * r); }
            else x = x + a * E.scale;
            u32x2 w; w.x = cvt_pk_bf16(x[0], x[1]); w.y = cvt_pk_bf16(x[2], x[3]); *(u32x2*)(E.XD + o) = w;
            if (E.RSO) { const float y0 = bflo(w.x), y1 = bfhi(w.x), y2 = bflo(w.y), y3 = bfhi(w.y); float ss = y0 * y0 + y1 * y1 + y2 * y2 + y3 * y3; ss += __shfl_xor(ss, 16); ss += __shfl_xor(ss, 32); if (fq == 0) atomicAdd(E.RSO + row, (u64)(long long)(ss * RS_FIX)); }
        }
    }
}

__device__ __forceinline__ int src_col(int map, int n) {
    if (map == 0) return n;
    if (map == 1) { const int pn = n >> 8, w = n & 255; return (w < 128) ? (pn * 128 + w) : (DFF + pn * 128 + (w - 128)); }
    if (n < 2560) return n;
    if (n < 3072) return n + 8;
    if (n < 3080) return 2560 + (n - 3072);
    return -1;
}
struct CvtItem { float v[32]; bf16_t* dp; const float* gn; int k0; bool zero; };
__device__ __forceinline__ void cvt_load(const Params& p, int l, int it, int lane, CvtItem& c) {
    bf16_t* wt = (bf16_t*)(p.ws + WS_WT) + (size_t)(l & 1) * W_TOTAL;
    const float* src; const float* gn = nullptr; int K, pitch, map, lt; bf16_t* dst;
    if (it < 2816)       { lt = it;         src = p.in[I_WF1I] + (size_t)l * 1024 * 5632; K = 1024; pitch = 5632; map = 1; dst = wt + W_F1IN; gn = p.in[I_NF1] + l * 1024; }
    else if (it < 4224)  { lt = it - 2816;  src = p.in[I_WF1O] + (size_t)l * 2816 * 1024; K = 2816; pitch = 1024; map = 0; dst = wt + W_F1OUT; }
    else if (it < 5888)  { lt = it - 4224;  src = p.in[I_WIN] + (size_t)l * 1024 * 3080;  K = 1024; pitch = 3080; map = 2; dst = wt + W_IN; gn = p.in[I_NMIX] + l * 1024; }
    else if (it < 6400)  { lt = it - 5888;  src = p.in[I_WOUT] + (size_t)l * 1024 * 1024; K = 1024; pitch = 1024; map = 0; dst = wt + W_OUT; }
    else if (it < 9216)  { lt = it - 6400;  src = p.in[I_WF2I] + (size_t)l * 1024 * 5632; K = 1024; pitch = 5632; map = 1; dst = wt + W_F2IN; gn = p.in[I_NF2] + l * 1024; }
    else if (it < 10624) { lt = it - 9216;  src = p.in[I_WF2O] + (size_t)l * 2816 * 1024; K = 2816; pitch = 1024; map = 0; dst = wt + W_F2OUT; }
    else if (it < 11136) { lt = it - 10624; src = p.in[I_WPG] + (size_t)l * 1024 * 1024;  K = 1024; pitch = 1024; map = 0; dst = wt + W_GATE; gn = p.in[I_NPLE] + l * 1024; }
    else                 { lt = it - 11136; src = p.in[I_WPP] + (size_t)l * 256 * 1024;   K = 256;  pitch = 1024; map = 0; dst = wt + W_PLE; }
    const int nkb = K >> 5, nb_ = lt / nkb, kb = lt - nb_ * nkb, n = nb_ * 64 + lane, k0 = kb * 32;
    int sc = src_col(map, n & ~3); if (sc >= 0) sc += (n & 3);
    const float* sp = src + (size_t)k0 * pitch + (sc >= 0 ? sc : 0);
#pragma unroll
    for (int j = 0; j < 32; ++j) c.v[j] = __builtin_nontemporal_load(sp + (size_t)j * pitch);
    c.dp = dst + (size_t)n * K + k0; c.gn = gn; c.k0 = k0; c.zero = sc < 0;
}
__device__ __forceinline__ void cvt_store(CvtItem& c) {
    if (c.zero) {
#pragma unroll
        for (int j = 0; j < 32; ++j) c.v[j] = 0.f; }
    if (c.gn) {
#pragma unroll
        for (int j = 0; j < 32; ++j) c.v[j] *= c.gn[c.k0 + j]; }
#pragma unroll
    for (int q = 0; q < 4; ++q) { u32x4 w; w.x = cvt_pk_bf16(c.v[q * 8], c.v[q * 8 + 1]); w.y = cvt_pk_bf16(c.v[q * 8 + 2], c.v[q * 8 + 3]); w.z = cvt_pk_bf16(c.v[q * 8 + 4], c.v[q * 8 + 5]); w.w = cvt_pk_bf16(c.v[q * 8 + 6], c.v[q * 8 + 7]); *(u32x4*)(c.dp + q * 8) = w; }
}
constexpr int CVT_ITEMS = 11264;
__device__ __forceinline__ void convert_p(const Params& p, int l, const Ctx& cx) {
    bf16_t* pb = (bf16_t*)(p.ws + WS_PB) + (size_t)(l & 1) * T * 256;
    for (int i = cx.bid * 512 + cx.tid; i < T * 32; i += cx.nb * 512) {
        const int row = i >> 5, c8 = (i & 31) * 8;
        const float* s = (row < TP) ? p.in[I_PP] + ((size_t)l * TP + row) * 256 + c8 : p.in[I_PS] + ((size_t)l * TS + (row - TP)) * 256 + c8;
        const f32x4 a = __builtin_nontemporal_load((const f32x4*)s), b = __builtin_nontemporal_load((const f32x4*)(s + 4));
        u32x4 w; w.x = cvt_pk_bf16(a[0], a[1]); w.y = cvt_pk_bf16(a[2], a[3]); w.z = cvt_pk_bf16(b[0], b[1]); w.w = cvt_pk_bf16(b[2], b[3]);
        *(u32x4*)(pb + (size_t)row * 256 + c8) = w;
    }
}
__device__ void phase_convert(const Params& p, int l, unsigned char* shm, const Ctx& cx) {
    const int wv = __builtin_amdgcn_readfirstlane(cx.tid >> 6), lane = cx.tid & 63;
    for (int it = cx.bid * 8 + wv; it < CVT_ITEMS; it += cx.nb * 8) { CvtItem c; cvt_load(p, l, it, lane, c); cvt_store(c); }
    convert_p(p, l, cx);
}

__device__ void phase_norm(const Params& p, const float* gain, bool first, bool final_, const Ctx& cx) {
    const int tid = cx.tid, wid = tid >> 6, lane = tid & 63;
    bf16_t* xb = (bf16_t*)(p.ws + WS_XN); const bf16_t* xl = (const bf16_t*)(p.ws + WS_MIX); u64* rowss = (u64*)(p.ws + WS_ROWSS);
    if (first) { for (int i = cx.bid * 512 + tid; i < 15 * T / 2; i += cx.nb * 512) ((f32x4*)(rowss + T))[i] = (f32x4){0.f, 0.f, 0.f, 0.f}; }
    f32x4 g[4];
#pragma unroll
    for (int i = 0; i < 4; ++i) g[i] = final_ ? *(const f32x4*)(gain + i * 256 + lane * 4) : (f32x4){1.f, 1.f, 1.f, 1.f};
    for (int row = cx.bid * 8 + wid; row < T; row += cx.nb * 8) {
        f32x4 v[4]; float ss = 0.f;
#pragma unroll
        for (int i = 0; i < 4; ++i) {
            if (first) { const float* s = (row < TP) ? p.in[I_XP] + (size_t)row * DM : p.in[I_XS] + (size_t)(row - TP) * DM; const f32x4 f = *(const f32x4*)(s + i * 256 + lane * 4);
                u32x2 w; w.x = cvt_pk_bf16(f[0], f[1]); w.y = cvt_pk_bf16(f[2], f[3]); *(u32x2*)(xb + (size_t)row * DM + i * 256 + lane * 4) = w;
                v[i] = (f32x4){bflo(w.x), bfhi(w.x), bflo(w.y), bfhi(w.y)}; }
            else { const u32x2 w = *(const u32x2*)(xl + (size_t)row * DM + i * 256 + lane * 4); v[i] = (f32x4){bflo(w.x), bfhi(w.x), bflo(w.y), bfhi(w.y)}; }
            ss += v[i][0] * v[i][0] + v[i][1] * v[i][1] + v[i][2] * v[i][2] + v[i][3] * v[i][3];
        }
        ss = red64(ss);
        const float r = rsqrtf(ss * (1.0f / 1024.0f) + EPS);
        if (first && lane == 0) rowss[row] = (u64)(long long)(ss * RS_FIX);
        if (final_) {
#pragma unroll
            for (int i = 0; i < 4; ++i) { f32x4 y = v[i] * r * g[i];
#if MK_TIME
                if (row == TP && lane == 0 && i == 0) {
                    const unsigned long long* st = (const unsigned long long*)(p.ws + WS_STAMP);
                    float w[12]; float bar = 0.f;
#pragma unroll
                    for (int k = 0; k < 12; ++k) w[k] = 0.f;
                    for (int ph = 0; ph < NPHASES - 1; ++ph) { const int s_ = ph < NPH_L ? ph : 1 + (ph - NPH_L) % (NPH_L - 1); const float d = (float)(long long)(st[2 * ph + 1] - st[2 * ph]) * 0.01f;
                        const float b = (float)(long long)(st[2 * ph + 2] - st[2 * ph + 1]) * 0.01f; bar += b;
#pragma unroll
                        for (int k = 0; k < 12; ++k) if (k == s_) w[k] += d; }
                    float n0, n1, n2;
                    if (MK_TIME == 1) { n0 = (w[1] + w[9]) * 0.05f; n1 = (w[2] + w[10]) * 0.1f; n2 = w[3] * 0.1f; }
                    else if (MK_TIME == 2) { n0 = w[4] * 0.1f; n1 = w[5] * 0.1f; n2 = w[6] * 0.1f; }
                    else if (MK_TIME == 3) { n0 = w[7] * 0.1f; n1 = (w[8] + w[11]) * 0.1f; n2 = bar * 0.05f; }
                    else if (MK_TIME == 4) { n0 = (w[2] + w[10]) * 0.1f; n1 = 0.f; n2 = 0.f; }
                    else if (MK_TIME == 5) { n0 = w[5] * 0.1f; n1 = 0.f; n2 = 0.f; }
                    else if (MK_TIME == 6) { n0 = w[6] * 0.1f; n1 = 0.f; n2 = 0.f; }
                    else if (MK_TIME == 7) { n0 = (w[8] + w[11]) * 0.1f; n1 = 0.f; n2 = 0.f; }
                    else if (MK_TIME == 8) { n0 = bar * 0.05f; n1 = 0.f; n2 = 0.f; }
                    else if (MK_TIME == 9) { n0 = w[3] * 0.1f; n1 = 0.f; n2 = 0.f; }
                    else if (MK_TIME == 10) { n0 = w[0] * 0.1f; n1 = 0.f; n2 = 0.f; }
                    else if (MK_TIME == 14) { n0 = (float)(long long)st[200] * 0.01f * 0.1f; n1 = 0.f; n2 = 0.f; }
                    else { n0 = 0.f; n1 = 0.f; n2 = 0.f; }
                    const int c0_ = min(99, (int)(n0 + 0.5f)), c1_ = min(99, (int)(n1 + 0.5f)), c2_ = min(99, (int)(n2 + 0.5f));
                    int P = c0_ * 10000 + c1_ * 100 + c2_;
                    if (MK_TIME == 11) P = 125000; if (MK_TIME == 12) P = 500000; if (MK_TIME == 13) P = 875000;
                    y[0] = 9.0f + 8.0f * (float)P * 1e-6f;
                }
#endif
                st16_wt(wt_rsrc(p.out), (O_Y + (size_t)row * DM + i * 256 + lane * 4) * 4, __builtin_bit_cast(u32x4, y)); }
        }
    }
}

struct PRaw { u32x4 zu, zv, pr[4][3]; float a4, b4; };
__device__ __forceinline__ void pi_load(const bf16_t* z, const float* zl, int t, int c0, int lane, PRaw& R) {
    const bf16_t* zr = z + (size_t)t * NIN; R.zu = *(const u32x4*)(zr + c0); R.zv = *(const u32x4*)(zr + 512 + c0);
    const int pos = t & 2047;
#pragma unroll
    for (int j = 0; j < 4; ++j) { const int tr = (pos - 3 + j >= 0) ? t - 3 + j : t;
#pragma unroll
        for (int grp = 0; grp < 3; ++grp) R.pr[j][grp] = *(const u32x4*)(z + (size_t)tr * NIN + 1024 + grp * 512 + c0); }
    R.a4 = zl[(size_t)t * 8 + (lane & 3)]; R.b4 = zl[(size_t)t * 8 + 4 + (lane & 3)];
}
__device__ __forceinline__ void pi_compute(const Params& p, int l, int t, int c0, int lane, const PRaw& R, const float (&gv)[8], const float* cw, float* cpo) {
    bf16_t* ub = (bf16_t*)(p.ws + WS_UB); bf16_t* vnb = (bf16_t*)(p.ws + WS_VNB);
    bf16_t* q16 = (bf16_t*)(p.ws + WS_Q16); bf16_t* k16 = (bf16_t*)(p.ws + WS_K16); bf16_t* v16 = (bf16_t*)(p.ws + WS_V16);
    float* gb = (float*)(p.ws + WS_GB); float* betab = (float*)(p.ws + WS_BETA);
    const int b = t >> 11, pos = t & 2047;
    float f[8], o[8];
    unpack8(R.zu, f);
#pragma unroll
    for (int e = 0; e < 8; ++e) o[e] = gelu_tanh(f[e]);
    st16_wt(wt_rsrc(ub), ((size_t)t * 512 + c0) * 2, pack8(o));
    unpack8(R.zv, f);
    float ss = 0.f;
#pragma unroll
    for (int e = 0; e < 8; ++e) { f[e] = gelu_tanh(f[e]); ss += f[e] * f[e]; }
    ss = red16(ss);
    { const float r = rsqrtf(ss * (1.0f / 128.0f) + EPS);
#pragma unroll
      for (int e = 0; e < 8; ++e) o[e] = f[e] * r * gv[e]; }
    st16_wt(wt_rsrc(vnb), ((size_t)t * 512 + c0) * 2, pack8(o));
#pragma unroll
    for (int grp = 0; grp < 3; ++grp) {
        const int ch = grp * 512 + c0;
        float y[8];
#pragma unroll
        for (int e = 0; e < 8; ++e) y[e] = 0.f;
#pragma unroll
        for (int j = 0; j < 4; ++j) {
            float pre[8]; unpack8(R.pr[j][grp], pre);
            const float msk = (pos - 3 + j >= 0) ? 1.0f : 0.0f;
            const f32x4 w0 = *(const f32x4*)(cw + j * 1536 + ch) * msk, w1 = *(const f32x4*)(cw + j * 1536 + ch + 4) * msk;
            y[0] += pre[0] * w0[0]; y[1] += pre[1] * w0[1]; y[2] += pre[2] * w0[2]; y[3] += pre[3] * w0[3];
            y[4] += pre[4] * w1[0]; y[5] += pre[5] * w1[1]; y[6] += pre[6] * w1[2]; y[7] += pre[7] * w1[3];
            if (j == 3 && pos >= 2045) { float* dst = cpo + ((size_t)b * 3 + (pos - 2045)) * 1536 + ch;
                *(f32x4*)dst = (f32x4){pre[0], pre[1], pre[2], pre[3]}; *(f32x4*)(dst + 4) = (f32x4){pre[4], pre[5], pre[6], pre[7]}; }
        }
        float s2 = 0.f;
#pragma unroll
        for (int e = 0; e < 8; ++e) { y[e] = siluf_(y[e]); s2 += y[e] * y[e]; }
        if (grp < 2) {
            s2 = red16(s2);
            const float r = rsqrtf(s2 + EPS) * (grp == 0 ? 0.08838834764831845f : 1.0f);
#pragma unroll
            for (int e = 0; e < 8; ++e) y[e] *= r;
        }
        st16_wt(wt_rsrc(grp == 0 ? q16 : (grp == 1 ? k16 : v16)), ((size_t)t * 512 + c0) * 2, pack8(y));
    }
    if (lane < 4) {
        const float a = R.a4 + p.in[I_BDT][l * 4 + lane];
        const float sp = (a > 20.f) ? a : log1pf(__expf(a));
        gb[(size_t)t * 4 + lane] = -__expf(p.in[I_BAL][l * 4 + lane]) * sp;
        betab[(size_t)t * 4 + lane] = sigmoidf_(R.b4);
    }
}
__device__ void phase_postin(const Params& p, int l, const Ctx& cx) {
    const int tid = cx.tid, wid = tid >> 6, lane = tid & 63, c0 = lane * 8, hd = lane >> 4, cd = c0 & 127;
    const bf16_t* z = (const bf16_t*)(p.ws + WS_F); const float* zl = (const float*)(p.ws + WS_ZL);
    bf16_t* ub = (bf16_t*)(p.ws + WS_UB); bf16_t* vnb = (bf16_t*)(p.ws + WS_VNB);
    bf16_t* q16 = (bf16_t*)(p.ws + WS_Q16); bf16_t* k16 = (bf16_t*)(p.ws + WS_K16); bf16_t* v16 = (bf16_t*)(p.ws + WS_V16);
    float* gb = (float*)(p.ws + WS_GB); float* betab = (float*)(p.ws + WS_BETA);
    const float* avg = p.in[I_AVG] + l * 128; const float* cw = p.in[I_BCW] + (size_t)l * 4 * 1536;
    const float* sc = p.in[I_SC] + (size_t)l * 128 * 3 * 1536;
    float* cpo = p.out + O_CP + (size_t)l * 8 * 3 * 1536; float* cso = p.out + O_CS + (size_t)l * 128 * 3 * 1536; float* cvo = p.out + O_CV + (size_t)l * TS * 512;
    float gv[8];
#pragma unroll
    for (int e = 0; e < 8; ++e) gv[e] = avg[cd + e];
    {
        const int stride = cx.nb * 8; int t = cx.bid * 8 + wid;
        if (t < TP) {
            PRaw R0, R1; pi_load(z, zl, t, c0, lane, R0);
            for (;;) {
                const int t1 = t + stride; const bool h1 = t1 < TP; pi_load(z, zl, h1 ? t1 : t, c0, lane, R1); pi_compute(p, l, t, c0, lane, R0, gv, cw, cpo); if (!h1) break;
                const int t2 = t1 + stride; const bool h2 = t2 < TP; pi_load(z, zl, h2 ? t2 : t1, c0, lane, R0); pi_compute(p, l, t1, c0, lane, R1, gv, cw, cpo); if (!h2) break;
                t = t2;
            }
        }
    }
    for (int t = TP + cx.bid * 8 + wid; t < T; t += cx.nb * 8) {
        const bool prompt = t < TP; const int b = prompt ? (t >> 11) : ((t - TP) >> 2), pos = prompt ? (t & 2047) : ((t - TP) & 3);
        const bf16_t* zr = z + (size_t)t * NIN;
        float f[8], o[8];
        unpack8(*(const u32x4*)(zr + c0), f);
#pragma unroll
        for (int e = 0; e < 8; ++e) o[e] = gelu_tanh(f[e]);
        *(u32x4*)(ub + (size_t)t * 512 + c0) = pack8(o);
        unpack8(*(const u32x4*)(zr + 512 + c0), f);
        float ss = 0.f;
#pragma unroll
        for (int e = 0; e < 8; ++e) { f[e] = gelu_tanh(f[e]); ss += f[e] * f[e]; }
        ss = red16(ss);
        { const float r = rsqrtf(ss * (1.0f / 128.0f) + EPS);
#pragma unroll
          for (int e = 0; e < 8; ++e) o[e] = f[e] * r * gv[e]; }
        *(u32x4*)(vnb + (size_t)t * 512 + c0) = pack8(o);
        if (!prompt) { float* q = cvo + (size_t)(t - TP) * 512 + c0; *(f32x4*)q = (f32x4){o[0], o[1], o[2], o[3]}; *(f32x4*)(q + 4) = (f32x4){o[4], o[5], o[6], o[7]}; }
#pragma unroll
        for (int grp = 0; grp < 3; ++grp) {
            const int ch = grp * 512 + c0;
            float y[8];
#pragma unroll
            for (int e = 0; e < 8; ++e) y[e] = 0.f;
#pragma unroll
            for (int j = 0; j < 4; ++j) {
                const int rp = pos - 3 + j;
                float pre[8];
                if (rp >= 0) unpack8(*(const u32x4*)(z + (size_t)(t - 3 + j) * NIN + 1024 + ch), pre);
                else if (!prompt) { const float* s = sc + ((size_t)b * 3 + (rp + 3)) * 1536 + ch; const f32x4 a = *(const f32x4*)s, bq = *(const f32x4*)(s + 4);
                    pre[0] = a[0]; pre[1] = a[1]; pre[2] = a[2]; pre[3] = a[3]; pre[4] = bq[0]; pre[5] = bq[1]; pre[6] = bq[2]; pre[7] = bq[3]; }
                else {
#pragma unroll
                    for (int e = 0; e < 8; ++e) pre[e] = 0.f; }
                const f32x4 w0 = *(const f32x4*)(cw + j * 1536 + ch), w1 = *(const f32x4*)(cw + j * 1536 + ch + 4);
                y[0] += pre[0] * w0[0]; y[1] += pre[1] * w0[1]; y[2] += pre[2] * w0[2]; y[3] += pre[3] * w0[3];
                y[4] += pre[4] * w1[0]; y[5] += pre[5] * w1[1]; y[6] += pre[6] * w1[2]; y[7] += pre[7] * w1[3];
                if (j == 3) {
                    float* dst = nullptr;
                    if (prompt) { if (pos >= 2045) dst = cpo + ((size_t)b * 3 + (pos - 2045)) * 1536 + ch; }
                    else if (pos >= 1) dst = cso + ((size_t)b * 3 + (pos - 1)) * 1536 + ch;
                    if (dst) { *(f32x4*)dst = (f32x4){pre[0], pre[1], pre[2], pre[3]}; *(f32x4*)(dst + 4) = (f32x4){pre[4], pre[5], pre[6], pre[7]}; }
                }
            }
            float s2 = 0.f;
#pragma unroll
            for (int e = 0; e < 8; ++e) { y[e] = siluf_(y[e]); s2 += y[e] * y[e]; }
            if (grp < 2) {
                s2 = red16(s2);
                const float r = rsqrtf(s2 + EPS) * (grp == 0 ? 0.08838834764831845f : 1.0f);
#pragma unroll
                for (int e = 0; e < 8; ++e) y[e] *= r;
            }
            bf16_t* dstb = (grp == 0 ? q16 : (grp == 1 ? k16 : v16)) + (size_t)t * 512 + c0;
            *(u32x4*)dstb = pack8(y);
        }
        if (lane < 4) {
            const float a = zl[(size_t)t * 8 + lane] + p.in[I_BDT][l * 4 + lane], bl = zl[(size_t)t * 8 + 4 + lane];
            const float sp = (a > 20.f) ? a : log1pf(__expf(a));
            gb[(size_t)t * 4 + lane] = -__expf(p.in[I_BAL][l * 4 + lane]) * sp;
            betab[(size_t)t * 4 + lane] = sigmoidf_(bl);
        }
    }
}

__device__ void phase_gmlp(const Params& p, int l, unsigned char* shm, const Ctx& cx) {
    const int tid = cx.tid, wid = tid >> 6, lane = tid & 63, fr = lane & 15, fq = lane >> 4;
    const bf16_t* ub = (const bf16_t*)(p.ws + WS_UB); const bf16_t* vnb = (const bf16_t*)(p.ws + WS_VNB); bf16_t* mix = (bf16_t*)(p.ws + WS_MIX);
    const float* aog = p.in[I_AOG] + l * 128;
    bf16_t* vs = (bf16_t*)shm;
    const __amdgpu_buffer_rsrc_t mixr = wt_rsrc(mix);
    constexpr int VP = 136;
    for (int unit = cx.bid; unit < 512; unit += cx.nb) {
        const int b = unit >> 6, n = (unit >> 2) & 15, h = unit & 3, trow0 = b * 2048 + n * 128;
        const float* w = p.in[I_ASW] + ((size_t)l * 4 + h) * 128 * 128; const float* bias = p.in[I_ASB] + ((size_t)l * 4 + h) * 128;
#pragma unroll
        for (int ps = 0; ps < 4; ++ps) { const int r = tid & 127, c8 = (ps * 4 + (tid >> 7)) * 8;
            const u32x4 w = __builtin_nontemporal_load((const u32x4*)(vnb + (size_t)(trow0 + r) * 512 + h * 128 + c8));
            vs[(c8 + 0) * VP + r] = (bf16_t)(w.x & 0xffffu); vs[(c8 + 1) * VP + r] = (bf16_t)(w.x >> 16); vs[(c8 + 2) * VP + r] = (bf16_t)(w.y & 0xffffu); vs[(c8 + 3) * VP + r] = (bf16_t)(w.y >> 16);
            vs[(c8 + 4) * VP + r] = (bf16_t)(w.z & 0xffffu); vs[(c8 + 5) * VP + r] = (bf16_t)(w.z >> 16); vs[(c8 + 6) * VP + r] = (bf16_t)(w.w & 0xffffu); vs[(c8 + 7) * VP + r] = (bf16_t)(w.w >> 16); }
        __syncthreads();
        const int t0 = wid * 16, tt = t0 + fr;
        f32x4 acc[8];
#pragma unroll
        for (int nb = 0; nb < 8; ++nb) acc[nb] = (f32x4){0.f, 0.f, 0.f, 0.f};
        for (int k0 = 0; k0 < t0 + 16; k0 += 32) {
            const float* wp = w + (size_t)tt * 128 + k0 + fq * 8;
            const f32x4 wa = *(const f32x4*)wp, wb = *(const f32x4*)(wp + 4);
            float wf[8] = {wa[0], wa[1], wa[2], wa[3], wb[0], wb[1], wb[2], wb[3]};
#pragma unroll
            for (int e = 0; e < 8; ++e) if (k0 + fq * 8 + e > tt) wf[e] = 0.f;
            const u32x4 wpk = pack8(wf); const bf16x8 wfrag = *(const bf16x8*)&wpk;
#pragma unroll
            for (int nb = 0; nb < 8; ++nb) {
                const bf16x8 vf = *(const bf16x8*)(vs + (nb * 16 + fr) * VP + k0 + fq * 8);
                acc[nb] = __builtin_amdgcn_mfma_f32_16x16x32_bf16(vf, wfrag, acc[nb], 0, 0, 0);
            }
        }
        const int row = trow0 + tt; const float bs = bias[tt];
        float ss = 0.f;
#pragma unroll
        for (int nb = 0; nb < 8; ++nb) {
            const u32x2 uw = __builtin_nontemporal_load((const u32x2*)(ub + (size_t)row * 512 + h * 128 + nb * 16 + fq * 4));
            acc[nb][0] = (acc[nb][0] + bs) * bflo(uw.x); acc[nb][1] = (acc[nb][1] + bs) * bfhi(uw.x); acc[nb][2] = (acc[nb][2] + bs) * bflo(uw.y); acc[nb][3] = (acc[nb][3] + bs) * bfhi(uw.y);
            ss += acc[nb][0] * acc[nb][0] + acc[nb][1] * acc[nb][1] + acc[nb][2] * acc[nb][2] + acc[nb][3] * acc[nb][3];
        }
        ss += __shfl_xor(ss, 16); ss += __shfl_xor(ss, 32);
        const float r = rsqrtf(ss * (1.0f / 128.0f) + EPS);
#pragma unroll
        for (int nb = 0; nb < 8; ++nb) {
            const f32x4 gg = *(const f32x4*)(aog + nb * 16 + fq * 4);
            u32x2 ow; ow.x = cvt_pk_bf16(acc[nb][0] * r * gg[0], acc[nb][1] * r * gg[1]); ow.y = cvt_pk_bf16(acc[nb][2] * r * gg[2], acc[nb][3] * r * gg[3]);
            __builtin_amdgcn_raw_buffer_store_b64(ow, mixr, (unsigned)(((size_t)row * DM + h * 128 + nb * 16 + fq * 4) * 2), 0, 16);
        }
        __syncthreads();
    }
    {
        const int c0 = lane * 8, hd = lane >> 4, cd = c0 & 127;
        for (int st = cx.bid * 8 + wid; st < TS; st += cx.nb * 8) {
            const int b = st >> 2, t = st & 3; const float* w = p.in[I_ASW] + ((size_t)l * 4 + hd) * 128 * 128 + t * 128;
            float mx[8]; const float bs = p.in[I_ASB][((size_t)l * 4 + hd) * 128 + t];
#pragma unroll
            for (int e = 0; e < 8; ++e) mx[e] = bs;
            for (int s = 0; s <= t; ++s) { float f[8]; unpack8(*(const u32x4*)(vnb + (size_t)(TP + b * 4 + s) * 512 + c0), f); const float ws_ = w[s];
#pragma unroll
                for (int e = 0; e < 8; ++e) mx[e] += ws_ * f[e]; }
            float uf[8]; unpack8(*(const u32x4*)(ub + (size_t)(TP + st) * 512 + c0), uf);
            float ss = 0.f;
#pragma unroll
            for (int e = 0; e < 8; ++e) { mx[e] *= uf[e]; ss += mx[e] * mx[e]; }
            ss = red16(ss);
            const float r = rsqrtf(ss * (1.0f / 128.0f) + EPS);
#pragma unroll
            for (int e = 0; e < 8; ++e) mx[e] = mx[e] * r * aog[cd + e];
            *(u32x4*)(mix + (size_t)(TP + st) * DM + c0) = pack8(mx);
        }
    }
}

__device__ void phase_delta_pre(const Params& p, unsigned char* shm, const Ctx& cx) {
    const int tid = cx.tid, half = tid >> 8, lt = tid & 255, lw = lt >> 6, lane = tid & 63, fr = lane & 15, fq = lane >> 4;
    const bf16_t* q16 = (const bf16_t*)(p.ws + WS_Q16); const bf16_t* k16 = (const bf16_t*)(p.ws + WS_K16); const bf16_t* v16 = (const bf16_t*)(p.ws + WS_V16);
    const float* gb = (const float*)(p.ws + WS_GB); const float* betab = (const float*)(p.ws + WS_BETA); float* btot = (float*)(p.ws + WS_BTOT);
    float* Lm = (float*)(shm + half * 32768);
    float* gam = (float*)(shm + half * 32768 + 16384);
    float* bet = gam + 64;
    for (int it = cx.bid; it < 512; it += cx.nb) {
        const int ck = it * 2 + half, b = ck >> 7, h = (ck >> 5) & 3, n = ck & 31, t0 = b * 2048 + n * 64;
        unsigned char* cb = p.ws + WS_CHUNK + (size_t)ck * CHUNK_BYTES;
        if (lt < 64) {
            float g = gb[(size_t)(t0 + lt) * 4 + h];
#pragma unroll
            for (int d = 1; d < 64; d <<= 1) { const float o = __shfl_up(g, d); if (lane >= d) g += o; }
            gam[lt] = g; bet[lt] = betab[(size_t)(t0 + lt) * 4 + h];
            if (lt == 63) btot[ck] = __expf(g);
        }
        __syncthreads();
        {
            const int rb = lw; bf16x8 ak[4], aq[4];
#pragma unroll
            for (int ks = 0; ks < 4; ++ks) { const size_t o = (size_t)(t0 + rb * 16 + fr) * 512 + h * 128 + ks * 32 + fq * 8; ak[ks] = *(const bf16x8*)(k16 + o); aq[ks] = *(const bf16x8*)(q16 + o); }
            bf16_t* qkd = (bf16_t*)(cb + CK_QKD);
            for (int sb = 0; sb < 4; ++sb) {
                f32x4 ckk = (f32x4){0.f, 0.f, 0.f, 0.f}, cqk = (f32x4){0.f, 0.f, 0.f, 0.f};
                if (sb <= rb) {
#pragma unroll
                    for (int ks = 0; ks < 4; ++ks) { const bf16x8 bk = *(const bf16x8*)(k16 + (size_t)(t0 + sb * 16 + fr) * 512 + h * 128 + ks * 32 + fq * 8);
                        ckk = __builtin_amdgcn_mfma_f32_16x16x32_bf16(ak[ks], bk, ckk, 0, 0, 0); cqk = __builtin_amdgcn_mfma_f32_16x16x32_bf16(aq[ks], bk, cqk, 0, 0, 0); }
                }
                const int s = sb * 16 + fr; const float gs = gam[s];
#pragma unroll
                for (int r = 0; r < 4; ++r) { const int c = rb * 16 + fq * 4 + r; const float dec = (s <= c) ? __expf(gam[c] - gs) : 0.f;
                    Lm[c * 64 + s] = (s < c) ? bet[c] * ckk[r] * dec : 0.f;
                    qkd[c * 64 + s] = (bf16_t)(cvt_pk_bf16(cqk[r] * dec, 0.f) & 0xffffu); }
            }
        }
        __syncthreads();
        {
            const int j = lt & 127; const bool isk = lt >= 128;
            const bf16_t* srcc = (isk ? k16 : v16) + (size_t)t0 * 512 + h * 128 + j;
            float x[64];
#pragma unroll
            for (int c = 0; c < 64; ++c) x[c] = bf2f(srcc[(size_t)c * 512]);
            if (isk) {
                const float gl = gam[63]; bf16_t* kendT = (bf16_t*)(cb + CK_KENDT) + j * 64;
#pragma unroll
                for (int c8 = 0; c8 < 64; c8 += 8) { float f[8];
#pragma unroll
                    for (int e = 0; e < 8; ++e) f[e] = x[c8 + e] * __expf(gl - gam[c8 + e]);
                    *(u32x4*)(kendT + c8) = pack8(f); }
#pragma unroll
                for (int c = 0; c < 64; ++c) x[c] *= bet[c] * __expf(gam[c]);
            } else {
                bf16_t* qb = (bf16_t*)(cb + CK_QB);
#pragma unroll
                for (int c = 0; c < 64; ++c) { const float qv = bf2f(q16[(size_t)(t0 + c) * 512 + h * 128 + j]) * __expf(gam[c]); qb[c * 128 + j] = (bf16_t)(cvt_pk_bf16(qv, 0.f) & 0xffffu); }
#pragma unroll
                for (int c = 0; c < 64; ++c) x[c] *= bet[c];
            }
#pragma unroll
            for (int c = 1; c < 64; ++c) {
                float a = x[c];
#pragma unroll
                for (int s4 = 0; s4 < c; s4 += 4) { const f32x4 lv = *(const f32x4*)(Lm + c * 64 + s4);
                    a -= lv[0] * x[s4]; if (s4 + 1 < c) a -= lv[1] * x[s4 + 1]; if (s4 + 2 < c) a -= lv[2] * x[s4 + 2]; if (s4 + 3 < c) a -= lv[3] * x[s4 + 3]; }
                x[c] = a;
            }
            if (isk) { bf16_t* nkb = (bf16_t*)(cb + CK_NKB);
#pragma unroll
                for (int c = 0; c < 64; ++c) nkb[c * 128 + j] = (bf16_t)(cvt_pk_bf16(-x[c], 0.f) & 0xffffu);
            } else { float* wT = (float*)(cb + CK_WT) + j * 64;
#pragma unroll
                for (int c = 0; c < 64; c += 4) *(f32x4*)(wT + c) = (f32x4){x[c], x[c + 1], x[c + 2], x[c + 3]};
            }
        }
        __syncthreads();
    }
}

__device__ void phase_delta_scan(const Params& p, int l, unsigned char* shm, const Ctx& cx) {
    const int tid = cx.tid, wid = tid >> 6, lane = tid & 63, fr = lane & 15, fq = lane >> 4;
    float* obuf = (float*)(p.ws + WS_OBUF); const float* btot = (const float*)(p.ws + WS_BTOT);
    {
        float* kq = (float*)shm;
        float* red1 = kq + 1024;
        float* red2 = red1 + 512;
        const bf16_t* q16 = (const bf16_t*)(p.ws + WS_Q16); const bf16_t* k16 = (const bf16_t*)(p.ws + WS_K16); const bf16_t* v16 = (const bf16_t*)(p.ws + WS_V16);
        const float* gb = (const float*)(p.ws + WS_GB); const float* betab = (const float*)(p.ws + WS_BETA);
        const int j = tid & 127, iq = tid >> 7;
        for (int sq = cx.bid; sq < 512; sq += cx.nb) {
            const int b = sq >> 2, h = sq & 3;
            const float* s0 = p.in[I_SS] + (((size_t)l * 128 + b) * 4 + h) * 16384; float* so = p.out + O_SS + (((size_t)l * 128 + b) * 4 + h) * 16384;
            float S[32];
#pragma unroll
            for (int ii = 0; ii < 32; ++ii) S[ii] = __builtin_nontemporal_load(s0 + (size_t)(iq * 32 + ii) * 128 + j);
            { const int t = tid >> 7, jj = tid & 127; const size_t o = (size_t)(TP + b * 4 + t) * 512 + h * 128 + jj; kq[t * 256 + jj] = bf2f(k16[o]); kq[t * 256 + 128 + jj] = bf2f(q16[o]); }
            __syncthreads();
            for (int t = 0; t < 4; ++t) {
                const int row = TP + b * 4 + t; const float a = __expf(gb[(size_t)row * 4 + h]), bt = betab[(size_t)row * 4 + h];
                const float* kv = kq + t * 256 + iq * 32; const float* qv = kq + t * 256 + 128 + iq * 32;
                float part = 0.f;
#pragma unroll
                for (int ii = 0; ii < 32; ++ii) part += kv[ii] * S[ii];
                red1[iq * 128 + j] = part;
                __syncthreads();
                const float kS = red1[j] + red1[128 + j] + red1[256 + j] + red1[384 + j];
                const float d = bt * (bf2f(v16[(size_t)row * 512 + h * 128 + j]) - a * kS);
                float part2 = 0.f;
#pragma unroll
                for (int ii = 0; ii < 32; ++ii) { S[ii] = a * S[ii] + kv[ii] * d; part2 += qv[ii] * S[ii]; }
                red2[iq * 128 + j] = part2;
                __syncthreads();
                if (iq == 0) obuf[(size_t)row * 512 + h * 128 + j] = red2[j] + red2[128 + j] + red2[256 + j] + red2[384 + j];
            }
#pragma unroll
            for (int ii = 0; ii < 32; ++ii) so[(size_t)(iq * 32 + ii) * 128 + j] = S[ii];
            __syncthreads();
        }
    }
    {
        bf16_t* ST = (bf16_t*)shm;
        bf16_t* uT = (bf16_t*)(shm + 16 * 136 * 2);
        constexpr int SP = 136, UP = 72;
        const int wv = __builtin_amdgcn_readfirstlane(wid); const bool roleU = wv < 4;
        const int cbk = (wv & 3) * 16, i0 = wv * 16;
        const bool do_cvt = l + 1 < NLAYER; int cit = do_cvt ? cx.bid * 8 + wv : CVT_ITEMS; const int cstride = cx.nb * 8;
        for (int item = cx.bid; item < 256; item += cx.nb) {
            const int bh = item >> 3, b = bh >> 2, h = bh & 3, j0 = (item & 7) * 16;
            f32x4 accS = (f32x4){0.f, 0.f, 0.f, 0.f};
            __syncthreads();
            for (int i = tid; i < 16 * SP / 2; i += 512) ((unsigned*)ST)[i] = 0u;
            bf16x8 a1[4], qk2[2], ke[2]; f32x4 w4; float bt;
            bf16x8 na1[4], nqk2[2], nke[2]; f32x4 nw4; float nbt;
#define SCAN_LOAD(ck_, A1, QK2, KE, W4, BT) do { const unsigned char* cb_ = p.ws + WS_CHUNK + (size_t)(ck_) * CHUNK_BYTES; \
                const bf16_t* A_ = (const bf16_t*)(cb_ + (roleU ? CK_NKB : CK_QB)) + (size_t)(cbk + fr) * 128 + fq * 8; \
                _Pragma("unroll") for (int ks = 0; ks < 4; ++ks) A1[ks] = *(const bf16x8*)(A_ + ks * 32); \
                const bf16_t* Q_ = (const bf16_t*)(cb_ + CK_QKD) + (size_t)(cbk + fr) * 64 + fq * 8; QK2[0] = *(const bf16x8*)Q_; QK2[1] = *(const bf16x8*)(Q_ + 32); \
                const bf16_t* K_ = (const bf16_t*)(cb_ + CK_KENDT) + (size_t)(i0 + fr) * 64 + fq * 8; KE[0] = *(const bf16x8*)K_; KE[1] = *(const bf16x8*)(K_ + 32); \
                W4 = *(const f32x4*)((const float*)(cb_ + CK_WT) + (size_t)(j0 + fr) * 64 + cbk + fq * 4); BT = btot[ck_]; } while (0)
            SCAN_LOAD(bh * 32, a1, qk2, ke, w4, bt);
            __syncthreads();
            for (int n = 0; n < 32; ++n) {
                if (n + 1 < 32) SCAN_LOAD(bh * 32 + n + 1, na1, nqk2, nke, nw4, nbt);
                CvtItem cv; const bool cvt_now = (n % 5 == 0) && cit < CVT_ITEMS;
                if (cvt_now) cvt_load(p, l + 1, cit, lane, cv);
                f32x4 acc = roleU ? w4 : (f32x4){0.f, 0.f, 0.f, 0.f};
#pragma unroll
                for (int ks = 0; ks < 4; ++ks) { const bf16x8 bb = *(const bf16x8*)(ST + fr * SP + ks * 32 + fq * 8); acc = __builtin_amdgcn_mfma_f32_16x16x32_bf16(a1[ks], bb, acc, 0, 0, 0); }
                if (roleU) { u32x2 w; w.x = cvt_pk_bf16(acc[0], acc[1]); w.y = cvt_pk_bf16(acc[2], acc[3]); *(u32x2*)(uT + fr * UP + cbk + fq * 4) = w; }
                __syncthreads();
                const bf16x8 u0 = *(const bf16x8*)(uT + fr * UP + fq * 8), u1 = *(const bf16x8*)(uT + fr * UP + 32 + fq * 8);
                if (!roleU) {
                    acc = __builtin_amdgcn_mfma_f32_16x16x32_bf16(qk2[0], u0, acc, 0, 0, 0);
                    acc = __builtin_amdgcn_mfma_f32_16x16x32_bf16(qk2[1], u1, acc, 0, 0, 0);
                    float* op = obuf + (size_t)(b * 2048 + n * 64 + cbk + fq * 4) * 512 + h * 128 + j0 + fr;
                    op[0] = acc[0]; op[512] = acc[1]; op[1024] = acc[2]; op[1536] = acc[3];
                }
                accS = accS * bt;
                accS = __builtin_amdgcn_mfma_f32_16x16x32_bf16(ke[0], u0, accS, 0, 0, 0);
                accS = __builtin_amdgcn_mfma_f32_16x16x32_bf16(ke[1], u1, accS, 0, 0, 0);
                { u32x2 w; w.x = cvt_pk_bf16(accS[0], accS[1]); w.y = cvt_pk_bf16(accS[2], accS[3]); *(u32x2*)(ST + fr * SP + i0 + fq * 4) = w; }
                __syncthreads();
#pragma unroll
                for (int ks = 0; ks < 4; ++ks) a1[ks] = na1[ks];
                qk2[0] = nqk2[0]; qk2[1] = nqk2[1]; ke[0] = nke[0]; ke[1] = nke[1]; w4 = nw4; bt = nbt;
                if (cvt_now) { cvt_store(cv); cit += cstride; }
            }
#undef SCAN_LOAD
            float* so = p.out + O_SP + (((size_t)l * 8 + b) * 4 + h) * 16384 + (size_t)(i0 + fq * 4) * 128 + j0 + fr;
            so[0] = accS[0]; so[128] = accS[1]; so[256] = accS[2]; so[384] = accS[3];
        }
        for (; cit < CVT_ITEMS; cit += cstride) { CvtItem c; cvt_load(p, l + 1, cit, lane, c); cvt_store(c); }
        if (do_cvt) convert_p(p, l + 1, cx);
    }
}

__device__ void phase_bout(const Params& p, int l, const Ctx& cx) {
    const int tid = cx.tid, wid = tid >> 6, lane = tid & 63, c0 = lane * 8, cd = c0 & 127;
    const float* obuf = (const float*)(p.ws + WS_OBUF); const bf16_t* z = (const bf16_t*)(p.ws + WS_F); bf16_t* mix = (bf16_t*)(p.ws + WS_MIX);
    const float* bog = p.in[I_BOG] + l * 128;
    float gv[8];
#pragma unroll
    for (int e = 0; e < 8; ++e) gv[e] = bog[cd + e];
    const int stride = cx.nb * 8; int t = cx.bid * 8 + wid; const __amdgpu_buffer_rsrc_t mixr = wt_rsrc(mix);
    if (t < T) {
        f32x4 a0 = __builtin_nontemporal_load((const f32x4*)(obuf + (size_t)t * 512 + c0)), b0 = __builtin_nontemporal_load((const f32x4*)(obuf + (size_t)t * 512 + c0 + 4)); u32x4 g0 = __builtin_nontemporal_load((const u32x4*)(z + (size_t)t * NIN + ZG + c0));
        for (;;) {
            const int tn = t + stride; const bool hn = tn < T; const int tl = hn ? tn : t;
            const f32x4 a1 = __builtin_nontemporal_load((const f32x4*)(obuf + (size_t)tl * 512 + c0)), b1 = __builtin_nontemporal_load((const f32x4*)(obuf + (size_t)tl * 512 + c0 + 4)); const u32x4 g1 = __builtin_nontemporal_load((const u32x4*)(z + (size_t)tl * NIN + ZG + c0));
            float o[8] = {a0[0], a0[1], a0[2], a0[3], b0[0], b0[1], b0[2], b0[3]}, gt[8];
            unpack8(g0, gt);
            float ss = 0.f;
#pragma unroll
            for (int e = 0; e < 8; ++e) ss += o[e] * o[e];
            ss = red16(ss);
            const float r = rsqrtf(ss * (1.0f / 128.0f) + EPS);
#pragma unroll
            for (int e = 0; e < 8; ++e) o[e] = o[e] * r * gv[e] * siluf_(gt[e]);
            st16_wt(mixr, ((size_t)t * DM + 512 + c0) * 2, pack8(o));
            if (!hn) break;
            a0 = a1; b0 = b1; g0 = g1; t = tn;
        }
    }
}

#if MK_TIME == 14
#define MINI_T0 __syncthreads(); const unsigned long long mt0 = __builtin_amdgcn_s_memrealtime();
#define MINI_T1 __syncthreads(); if (cx.bid == 0 && cx.tid == 0) ((unsigned long long*)(p.ws + WS_STAMP))[200] += __builtin_amdgcn_s_memrealtime() - mt0;
#else
#define MINI_T0
#define MINI_T1
#endif
__device__ __forceinline__ void run_phase(const Params& p, int ph, unsigned char* shm, const Ctx& cx, const int rep) {
    if (ph == NPHASES - 1) { phase_norm(p, p.in[I_FN], false, true, cx); return; }
    const int l = ph < NPH_L ? 0 : 1 + (ph - NPH_L) / (NPH_L - 1), s = ph < NPH_L ? ph : 1 + (ph - NPH_L) % (NPH_L - 1);
    PG8_LAS unsigned char* lds = (PG8_LAS unsigned char*)shm;
    const bf16_t* wt = (const bf16_t*)(p.ws + WS_WT) + (size_t)(l & 1) * W_TOTAL; const bf16_t* pbl = (const bf16_t*)(p.ws + WS_PB) + (size_t)(l & 1) * T * 256;
    const bf16_t* xb = (const bf16_t*)(p.ws + WS_XN); bf16_t* hb = (bf16_t*)(p.ws + WS_F);
    u64* rss = (u64*)(p.ws + WS_ROWSS) + (size_t)l * 4 * T;
    const float rsc = rep ? 0.f : 1.f;
    switch (s) {
    case 0: phase_convert(p, l, shm, cx); if (l == 0) phase_norm(p, nullptr, true, false, cx); break;
    case 1: { EpiSwiGLU E; E.H = hb; E.RS = rss; run_gemm(lds, l == 0 ? xb : (const bf16_t*)(p.ws + WS_MIX), wt + W_F1IN, 5632, 1024, E, cx); } break;
    case 2: { EpiResidT<false> E; E.XS = l == 0 ? xb : (const bf16_t*)(p.ws + WS_MIX); E.XD = (bf16_t*)(p.ws + WS_XN); E.RSO = rep ? nullptr : rss + T; E.scale = 0.5f * rsc; E.PP = nullptr; E.RS = nullptr; run_gemm(lds, hb, wt + W_F1OUT, 1024, 2816, E, cx, TP); MINI_T0 mini_gemm_sample<0>(hb, wt + W_F1OUT, 2816, E, cx, shm); MINI_T1 } break;
    case 3: { EpiZ E; E.Z = hb; E.ZL = (float*)(p.ws + WS_ZL); E.RS = rss + T; run_gemm(lds, xb, wt + W_IN, NIN, 1024, E, cx); } break;
    case 4: phase_postin(p, l, cx); break;
    case 5: phase_gmlp(p, l, shm, cx); __syncthreads(); phase_delta_pre(p, shm, cx); break;
    case 6: phase_delta_scan(p, l, shm, cx); break;
    case 7: { phase_bout(p, l, cx); __syncthreads();
              EpiStoreBf16 E; E.C = (bf16_t*)(p.ws + WS_PP); run_gemm(lds, pbl, wt + W_PLE, 1024, 256, E, cx, TP);
              EpiResidT<false> M; M.XS = nullptr; M.XD = (bf16_t*)(p.ws + WS_PP); M.RSO = nullptr; M.scale = 0.f; M.PP = nullptr; M.RS = nullptr; MINI_T0 mini_gemm_sample<2>(pbl, wt + W_PLE, 256, M, cx, shm); MINI_T1 } break;
    case 8: { EpiResidT<false> E; E.XS = xb; E.XD = (bf16_t*)(p.ws + WS_XN); E.RSO = rep ? nullptr : rss + 2 * T; E.scale = rsc; E.PP = nullptr; E.RS = nullptr; run_gemm(lds, (const bf16_t*)(p.ws + WS_MIX), wt + W_OUT, 1024, 1024, E, cx, TP); MINI_T0 mini_gemm_sample<0>((const bf16_t*)(p.ws + WS_MIX), wt + W_OUT, 1024, E, cx, shm); MINI_T1 } break;
    case 9: { EpiSwiGLU E; E.H = hb; E.RS = rss + 2 * T; run_gemm(lds, xb, wt + W_F2IN, 5632, 1024, E, cx); } break;
    case 10: { EpiResidT<false> E; E.XS = xb; E.XD = (bf16_t*)(p.ws + WS_XN); E.RSO = rep ? nullptr : rss + 3 * T; E.scale = 0.5f * rsc; E.PP = nullptr; E.RS = nullptr; run_gemm(lds, hb, wt + W_F2OUT, 1024, 2816, E, cx, TP); MINI_T0 mini_gemm_sample<0>(hb, wt + W_F2OUT, 2816, E, cx, shm); MINI_T1 } break;
    default: { EpiResidT<true> E; E.XS = xb; E.XD = (bf16_t*)(p.ws + WS_MIX); E.RSO = (l == NLAYER - 1 || rep) ? nullptr : rss + 4 * T; E.scale = 1.f; E.PP = (const bf16_t*)(p.ws + WS_PP); E.RS = rss + 3 * T;
                 run_gemm(lds, xb, wt + W_GATE, 1024, 1024, E, cx, TP); MINI_T0 mini_gemm_sample<1>(xb, wt + W_GATE, 1024, E, cx, shm); MINI_T1 } break;
    }
}

__global__ __launch_bounds__(512, 2) void mk_fwd(Params p) {
    extern __shared__ __attribute__((aligned(16))) unsigned char shm[];
    cg::grid_group grid = cg::this_grid();
    const int lo = p.ph_lo, hi = p.ph_hi;
    if (hi > 100000) grid.sync();
    volatile LAS unsigned* bst = (volatile LAS unsigned*)(shm + pg8::STAGE_BYTES);
    if (threadIdx.x < 4) bst[threadIdx.x] = 0u;
    __syncthreads();
    const XcdBarrier gbar = xcd_barrier_post((unsigned*)(p.ws + WS_BAR), bst);
#ifndef MK_REP
#define MK_REP 0
#endif
#if MK_TIME
    if (blockIdx.x == 0 && threadIdx.x == 0) ((unsigned long long*)(p.ws + WS_STAMP))[200] = 0ull;
#endif
    for (int ph = lo; ph < hi; ++ph) {
#if MK_TIME
        __syncthreads(); if (blockIdx.x == 0 && threadIdx.x == 0 && ph > lo) ((unsigned long long*)(p.ws + WS_STAMP))[2 * (ph - 1) + 1] = __builtin_amdgcn_s_memrealtime();
#endif
        if (ph > lo) xcd_barrier(gbar);
#if MK_TIME
        if (blockIdx.x == 0 && threadIdx.x == 0) ((unsigned long long*)(p.ws + WS_STAMP))[2 * ph] = __builtin_amdgcn_s_memrealtime();
#endif
        const int nrep = 1;
        for (int rep = 0; rep < nrep; ++rep) {
            if (rep) __syncthreads();
            const __attribute__((address_space(4))) Params* kp = (const __attribute__((address_space(4))) Params*)__builtin_amdgcn_kernarg_segment_ptr();
            asm volatile("" : "+s"(kp));
            Ctx cx; cx.tid = threadIdx.x; cx.bid = blockIdx.x; cx.nb = gridDim.x;
            asm volatile("" : "+v"(cx.tid)); asm volatile("" : "+s"(cx.bid), "+s"(cx.nb));
            run_phase(*(const Params*)kp, ph, shm, cx, rep);
        }
    }
}

#ifndef MK_DIAG
#define MK_DIAG 0
#endif
#if MK_DIAG
__device__ __forceinline__ unsigned hsh(unsigned x) { x ^= x >> 16; x *= 0x7feb352du; x ^= x >> 15; x *= 0x846ca68bu; x ^= x >> 16; return x; }
__device__ __forceinline__ bool bad(float got, float ref, float rel, float ab) { return !(fabsf(got - ref) <= rel * fabsf(ref) + ab); }
__global__ void diag_kernel(Params p, int ph) {
    unsigned* flags = (unsigned*)(p.ws + WS_END);
    const int i = threadIdx.x; const int l = 0;
    const bf16_t* wt = (const bf16_t*)(p.ws + WS_WT); const bf16_t* xn = (const bf16_t*)(p.ws + WS_XN); const bf16_t* F = (const bf16_t*)(p.ws + WS_F); const float* xres = (const float*)(p.ws + WS_XRES);
    if (ph == -1) { if (i == 0) flags[0] = 0u; return; }
    if (ph == 100) { if (i == 0) p.out[0] = exp2f((float)(flags[0] & 127u)); return; }
    bool f = false; int bit = -1;
    const bf16_t* q16 = (const bf16_t*)(p.ws + WS_Q16); const bf16_t* k16 = (const bf16_t*)(p.ws + WS_K16); const bf16_t* v16 = (const bf16_t*)(p.ws + WS_V16);
    const float* gb = (const float*)(p.ws + WS_GB); const float* betab = (const float*)(p.ws + WS_BETA); const float* obuf = (const float*)(p.ws + WS_OBUF);
    if (ph == 0) { bit = 6;
        { const int n = hsh(i) % 5632, k = hsh(i + 1000) % 1024; const int sc = src_col(1, n & ~3) + (n & 3); f |= bad(bf2f(wt[W_F2IN + (size_t)n * 1024 + k]), p.in[I_WF2I][(size_t)k * 5632 + sc], 0.01f, 1e-6f); }
        { const int n = hsh(i + 2) % 1024, k = hsh(i + 1002) % 2816; f |= bad(bf2f(wt[W_F2OUT + (size_t)n * 2816 + k]), p.in[I_WF2O][(size_t)k * 1024 + n], 0.01f, 1e-6f); }
        { const int n = hsh(i + 3) % 1024, k = hsh(i + 1003) % 1024; f |= bad(bf2f(wt[W_OUT + (size_t)n * 1024 + k]), p.in[I_WOUT][(size_t)k * 1024 + n], 0.01f, 1e-6f); }
        { const int n = hsh(i + 4) % 1024, k = hsh(i + 1004) % 1024; f |= bad(bf2f(wt[W_GATE + (size_t)n * 1024 + k]), p.in[I_WPG][(size_t)k * 1024 + n], 0.01f, 1e-6f); }
    }
    if (ph == 6) {
        const int ck = hsh(i / 64 + 900) % 1024, b = ck >> 7, h = (ck >> 5) & 3, n = ck & 31, t0 = b * 2048 + n * 64;
        const unsigned char* cb = p.ws + WS_CHUNK + (size_t)ck * CHUNK_BYTES;
        const int c = hsh(i + 31) % 64, j = hsh(i + 32) % 128, s_ = hsh(i + 33) % 64;
        float gamc = 0.f, gams = 0.f, gl = 0.f, run = 0.f;
        for (int t = 0; t < 64; ++t) { run += gb[(size_t)(t0 + t) * 4 + h]; if (t == c) gamc = run; if (t == s_) gams = run; if (t == 63) gl = run; }
        const float bc = betab[(size_t)(t0 + c) * 4 + h];
        float lw_ = 0.f, lk_ = 0.f, g2 = 0.f;
        const float* wT = (const float*)(cb + CK_WT) + (size_t)j * 64; const bf16_t* nkb = (const bf16_t*)(cb + CK_NKB);
        for (int s = 0; s < c; ++s) { g2 += gb[(size_t)(t0 + s) * 4 + h]; float kk = 0.f; for (int e = 0; e < 128; ++e) kk += bf2f(k16[(size_t)(t0 + c) * 512 + h * 128 + e]) * bf2f(k16[(size_t)(t0 + s) * 512 + h * 128 + e]);
            const float L = bc * kk * expf(gamc - g2); lw_ += L * wT[s]; lk_ += L * (-bf2f(nkb[s * 128 + j])); }
        const float rw = bc * bf2f(v16[(size_t)(t0 + c) * 512 + h * 128 + j]), rk = bc * expf(gamc) * bf2f(k16[(size_t)(t0 + c) * 512 + h * 128 + j]);
        if (bad(lw_ + wT[c], rw, 0.02f, 0.003f)) atomicOr(flags, 1u);
        if (bad(lk_ - bf2f(nkb[c * 128 + j]), rk, 0.03f, 0.002f)) atomicOr(flags, 2u);
        { float qk = 0.f; for (int e = 0; e < 128; ++e) qk += bf2f(q16[(size_t)(t0 + c) * 512 + h * 128 + e]) * bf2f(k16[(size_t)(t0 + s_) * 512 + h * 128 + e]);
          const float ref = (s_ <= c) ? qk * expf(gamc - gams) : 0.f; if (bad(bf2f(((const bf16_t*)(cb + CK_QKD))[c * 64 + s_]), ref, 0.03f, 0.0005f)) atomicOr(flags, 4u); }
        { bool g = false; g |= bad(bf2f(((const bf16_t*)(cb + CK_QB))[c * 128 + j]), bf2f(q16[(size_t)(t0 + c) * 512 + h * 128 + j]) * expf(gamc), 0.02f, 1e-5f);
          g |= bad(bf2f(((const bf16_t*)(cb + CK_KENDT))[j * 64 + c]), bf2f(k16[(size_t)(t0 + c) * 512 + h * 128 + j]) * expf(gl - gamc), 0.02f, 1e-5f);
          g |= bad(((const float*)(p.ws + WS_BTOT))[ck], expf(gl), 0.01f, 1e-30f); if (g) atomicOr(flags, 8u); }
    }
    if (ph == 7) {
        const int wv = i >> 6, lane = i & 63;
        {
            const int b = (wv * 3 + 1) & 7, h = wv & 3, j = (wv * 37 + 5) & 127;
            float s0 = 0.f, s1 = 0.f, maxerr = 0.f, maxref = 0.f; bool f4 = false;
            for (int t = 0; t < 2048; ++t) { const size_t r = (size_t)(b * 2048 + t); const float k0 = bf2f(k16[r * 512 + h * 128 + lane]), k1 = bf2f(k16[r * 512 + h * 128 + 64 + lane]);
                const float q0 = bf2f(q16[r * 512 + h * 128 + lane]), q1 = bf2f(q16[r * 512 + h * 128 + 64 + lane]); const float a = expf(gb[r * 4 + h]), bt = betab[r * 4 + h];
                const float kS = red64(k0 * s0 + k1 * s1); const float d = bt * (bf2f(v16[r * 512 + h * 128 + j]) - a * kS); s0 = a * s0 + k0 * d; s1 = a * s1 + k1 * d;
                const float o = red64(q0 * s0 + q1 * s1); maxerr = fmaxf(maxerr, fabsf(o - obuf[r * 512 + h * 128 + j])); maxref = fmaxf(maxref, fabsf(o));
                if (t == 63) f4 = !(maxerr <= 0.05f * maxref + 1e-4f); }
            if (f4) atomicOr(flags, 16u);
            if (!(maxerr <= 0.05f * maxref + 1e-4f)) atomicOr(flags, 32u);
        }
    }
    if (bit >= 0 && f) atomicOr(flags, 1u << bit);
}
#endif
#ifndef MK_ONE_LAUNCH
#define MK_ONE_LAUNCH 1
#endif
extern "C" void kernel_launch(void* const* d_in, const int* in_sizes, int n_in, void* d_out, int out_size, void* d_ws, size_t ws_size, hipStream_t stream) {
    static int grid = 0;
    if (grid == 0) {
        if (n_in != 27 || (size_t)out_size != O_END || ws_size < WS_END + 256) { fprintf(stderr, "kernel_launch: unexpected shapes (n_in %d out %d ws %zu need %zu)\n", n_in, out_size, ws_size, (size_t)WS_END); grid = -1; return; }
        int dev = 0, cus = 0, per_cu = 0;
        hipGetDevice(&dev); hipDeviceGetAttribute(&cus, hipDeviceAttributeMultiprocessorCount, dev);
        if (hipFuncSetAttribute((const void*)mk_fwd, hipFuncAttributeMaxDynamicSharedMemorySize, LDS_BYTES) != hipSuccess) { fprintf(stderr, "kernel_launch: hipFuncSetAttribute failed\n"); grid = -1; return; }
        if (hipOccupancyMaxActiveBlocksPerMultiprocessor(&per_cu, (const void*)mk_fwd, 512, LDS_BYTES) != hipSuccess || per_cu < 1) { fprintf(stderr, "kernel_launch: occupancy query says %d\n", per_cu); per_cu = 1; }
        (void)hipGetLastError();
        grid = cus * 1;
    }
    if (grid < 0) return;
    Params p{};
    for (int i = 0; i < 27; ++i) p.in[i] = (const float*)d_in[i];
    p.out = (float*)d_out; p.ws = (unsigned char*)d_ws;
    if (hipMemsetAsync((char*)d_ws + WS_BAR, 0, XCD_BAR_WORDS * 4, stream) != hipSuccess) { fprintf(stderr, "kernel_launch: memset of the barrier words failed\n"); return; }
#if MK_ONE_LAUNCH
    p.ph_lo = 0; p.ph_hi = NPHASES;
    void* args[] = {&p};
    hipError_t e = hipLaunchCooperativeKernel((const void*)mk_fwd, dim3(grid), dim3(512), args, LDS_BYTES, stream);
    if (e != hipSuccess) fprintf(stderr, "cooperative launch failed: %s (grid %d)\n", hipGetErrorString(e), grid);
#else
#if MK_DIAG
    hipLaunchKernelGGL(diag_kernel, dim3(1), dim3(256), 0, stream, p, -1);
#endif
    for (int ph = 0; ph < NPHASES; ++ph) { p.ph_lo = ph; p.ph_hi = ph + 1; hipLaunchKernelGGL(mk_fwd, dim3(grid), dim3(512), LDS_BYTES, stream, p);
#if MK_DIAG
        p.ph_lo = 0; p.ph_hi = 0; if (ph < 16) hipLaunchKernelGGL(diag_kernel, dim3(1), dim3(256), 0, stream, p, ph);
#endif
    }
#if MK_DIAG
    p.ph_lo = 0; p.ph_hi = 0; hipLaunchKernelGGL(diag_kernel, dim3(1), dim3(256), 0, stream, p, 100);
#endif
#endif
}
```

```cpp
#include <hip/hip_runtime.h>
#include <hip/hip_cooperative_groups.h>
#include <cstdio>
#include <cstdint>
namespace cg = cooperative_groups;
#ifndef MK_SP2
#define MK_SP2 true
#endif
#ifndef MK_ALIGN
#define MK_ALIGN true
#endif
#ifndef MK_TIME
#define MK_TIME 0
#endif

namespace pg8 {
#define PG8_LAS __attribute__((address_space(3)))
typedef unsigned short bf16_t;
typedef short bf16x8 __attribute__((ext_vector_type(8)));
typedef float f32x4 __attribute__((ext_vector_type(4)));
typedef unsigned u32x4 __attribute__((ext_vector_type(4)));
constexpr int BM = 256, BK = 64, HALF = 128, HTB = HALF * BK * 2  , STAGE_BYTES = 8 * HTB, NXCD = 8, WGM = 8;

__host__ __device__ __forceinline__ int lds_byte(int r, int c) { const int st = (r >> 4) * 2 + (c >> 5), rr = r & 15, cc = c & 31, ob = rr * 64 + cc * 2; return st * 1024 + (ob ^ (((ob >> 9) & 1) << 5)); }
__host__ __device__ __forceinline__ void stage_rc(int b, int& R, int& C) { const int st = b / 1024, sb = b % 1024, swz = sb ^ (((sb >> 9) & 1) << 5); R = (st >> 1) * 16 + swz / 64; C = (st & 1) * 32 + (swz % 64) / 2; }
__host__ __device__ __forceinline__ int perm32(int rho) { const int n = rho >> 4, i = rho & 15; return 8 * (i >> 2) + 4 * n + (i & 3); }

struct Unit { int pm, pn; };
struct Gemm { const bf16_t* A; const bf16_t* Bt; int M, N, K; };

struct StaticOrder {
    int nM, nN, nwg, G, c;
    __host__ __device__ void init(int M, int N, int G_, int c_) { nM = M / BM; nN = N / BM; nwg = nM * nN; G = G_; c = c_; }
    __host__ __device__ bool next(int i, Unit& u) const {
        const long L = (long)i * G + c; if (L >= nwg) return false;
        int wgid = (int)L; { const int q = nwg / NXCD, r = nwg % NXCD, xcd = wgid % NXCD, off = wgid / NXCD; wgid = (xcd < r ? xcd * (q + 1) : r * (q + 1) + (xcd - r) * q) + off; }
        const int nig = WGM * nN, gid = wgid / nig, fm = gid * WGM, gsz = (nM - fm) < WGM ? (nM - fm) : WGM;
        u.pm = fm + ((wgid % nig) % gsz); u.pn = (wgid % nig) / gsz; return true;
    }
    __device__ __forceinline__ void a_ready(const Unit&) const {}
    __device__ __forceinline__ void done(const Unit&) const {}
};
typedef __bf16 bf16x2_t __attribute__((ext_vector_type(2)));
typedef float f32x2_t __attribute__((ext_vector_type(2)));
__device__ __forceinline__ unsigned cvt_pk_bf16(float lo, float hi) { const f32x2_t f = {lo, hi}; const bf16x2_t v = __builtin_convertvector(f, bf16x2_t); return __builtin_bit_cast(unsigned, v); }
template <class Epi, class Sched, bool ALIGN_EPI = false, bool SP2 = false>
__device__ __forceinline__ void gemm_phase(PG8_LAS unsigned char* lds, const Gemm g, const Sched& S, const Epi& E, const int tid) {
    const int wid = __builtin_amdgcn_readfirstlane(tid >> 6), lane = tid & 63, wr = wid >> 2, wc = wid & 3, fr = lane & 15, fq = lane >> 4;
    const int K = g.K, nt = K / BK;
    unsigned voffA[2], voffB[2];
#pragma unroll
    for (int i = 0; i < 2; ++i) { int R, C; stage_rc(tid * 16 + i * 8192, R, C); const int Rb = Epi::PERM ? ((R & ~31) + perm32(R & 31)) : R;
        voffA[i] = (unsigned)(R * K + C) * 2u; voffB[i] = (unsigned)(Rb * K + C) * 2u; }
    const size_t kstep = (size_t)(BK * 2);
    const size_t hstep = (size_t)HALF * K * 2;
    const size_t tstep = 2 * hstep;
    const unsigned ldsw = (unsigned)wid * 1024u;
    const int aoff = lds_byte(wr * 64 + fr, fq * 8), boff = lds_byte(wc * 32 + fr, fq * 8);
#define PG8_SA(b, h) (((b) * 2 + (h)) * HTB)
#define PG8_SB(b, h) ((4 + (b) * 2 + (h)) * HTB)
#define PG8_STAGE(bufoff, gbase, voff) do { _Pragma("unroll") for (int _i = 0; _i < 2; ++_i) \
        __builtin_amdgcn_global_load_lds((const unsigned*)((const char*)(gbase) + (voff)[_i]), (PG8_LAS unsigned*)(lds + (bufoff) + ldsw + _i * 8192), 16, 0, 0); } while (0)
#define PG8_LDA(dst, b, h) do { _Pragma("unroll") for (int m = 0; m < 4; ++m) _Pragma("unroll") for (int k = 0; k < 2; ++k) dst[m][k] = *(const PG8_LAS bf16x8*)(lds + PG8_SA(b, h) + aoff + m * 2048 + k * 1024); } while (0)
#define PG8_LDB(dst, b, h) do { _Pragma("unroll") for (int n = 0; n < 2; ++n) _Pragma("unroll") for (int k = 0; k < 2; ++k) dst[n][k] = *(const PG8_LAS bf16x8*)(lds + PG8_SB(b, h) + boff + n * 2048 + k * 1024); } while (0)
#define PG8_MMA(ai, bj, At, Bt) do { __builtin_amdgcn_s_setprio(1); _Pragma("unroll") for (int m = 0; m < 4; ++m) _Pragma("unroll") for (int n = 0; n < 2; ++n) _Pragma("unroll") for (int k = 0; k < 2; ++k) \
        acc[ai][bj][m][n] = __builtin_amdgcn_mfma_f32_16x16x32_bf16(Bt[n][k], At[m][k], acc[ai][bj][m][n], 0, 0, 0); __builtin_amdgcn_s_setprio(0); } while (0)
#define PG8_WAIT_V(n) asm volatile("s_waitcnt vmcnt(" #n ")" ::: "memory")
#define PG8_WAIT_L(n) asm volatile("s_waitcnt lgkmcnt(" #n ")" ::: "memory")
#define PG8_BAR __builtin_amdgcn_s_barrier()
#define PG8_SCHED __builtin_amdgcn_sched_barrier(0)
    Unit cur, nxt; int ui = 0;
    if (!S.next(0, cur)) return;
    f32x4 acc[2][2][4][2];
#pragma unroll
    for (int a = 0; a < 2; ++a)
#pragma unroll
        for (int b = 0; b < 2; ++b)
#pragma unroll
            for (int m = 0; m < 4; ++m)
#pragma unroll
                for (int n = 0; n < 2; ++n) acc[a][b][m][n] = (f32x4){0.f, 0.f, 0.f, 0.f};
    bf16x8 At[4][2], B0[2][2], B1[2][2];
    const char* cA = (const char*)g.A + (size_t)cur.pm * tstep; const char* cB = (const char*)g.Bt + (size_t)cur.pn * tstep;
    S.a_ready(cur);
    if constexpr (SP2) {
        PG8_STAGE(PG8_SB(0, 0), cB, voffB); PG8_STAGE(PG8_SB(0, 1), cB + hstep, voffB); PG8_STAGE(PG8_SA(0, 0), cA, voffA); PG8_STAGE(PG8_SA(0, 1), cA + hstep, voffA);
        if (wr == 1) PG8_BAR;
        PG8_WAIT_V(2); PG8_BAR;
        PG8_STAGE(PG8_SB(1, 0), cB + kstep, voffB); PG8_STAGE(PG8_SA(1, 0), cA + kstep, voffA); PG8_STAGE(PG8_SB(1, 1), cB + hstep + kstep, voffB);
        PG8_WAIT_V(6); PG8_BAR;
    } else {
        PG8_STAGE(PG8_SB(0, 0), cB, voffB); PG8_STAGE(PG8_SA(0, 0), cA, voffA); PG8_STAGE(PG8_SB(0, 1), cB + hstep, voffB); PG8_STAGE(PG8_SA(0, 1), cA + hstep, voffA);
        if (wr == 1) PG8_BAR;
        PG8_WAIT_V(4); PG8_BAR;
        PG8_STAGE(PG8_SB(1, 0), cB + kstep, voffB); PG8_STAGE(PG8_SA(1, 0), cA + kstep, voffA); PG8_STAGE(PG8_SB(1, 1), cB + hstep + kstep, voffB);
        PG8_WAIT_V(6); PG8_BAR;
    }
    for (;;) {
        const bool has_next = S.next(ui + 1, nxt);
        const char* nA = has_next ? (const char*)g.A + (size_t)nxt.pm * tstep : cA; const char* nB = has_next ? (const char*)g.Bt + (size_t)nxt.pn * tstep : cB;
        for (int t = 0; t < nt; t += 2) {
            const bool last = (t == nt - 2);
            const char* a1 = cA + (size_t)(t + 1) * kstep;
            const char* a2 = last ? nA : cA + (size_t)(t + 2) * kstep; const char* b2 = last ? nB : cB + (size_t)(t + 2) * kstep;
            const char* a3 = a2 + kstep; const char* b3 = b2 + kstep;
            if (last && has_next) S.a_ready(nxt);
            if constexpr (SP2) {
            PG8_LDB(B0, 0, 0); PG8_LDB(B1, 0, 1); PG8_SCHED; PG8_LDA(At, 0, 0); PG8_STAGE(PG8_SA(1, 1), a1 + hstep, voffA);
            PG8_WAIT_V(8); PG8_WAIT_L(0); PG8_BAR; PG8_MMA(0, 0, At, B0); PG8_MMA(0, 1, At, B1); PG8_BAR; PG8_SCHED;
            PG8_LDA(At, 0, 1); PG8_STAGE(PG8_SB(0, 0), b2, voffB); PG8_STAGE(PG8_SB(0, 1), b2 + hstep, voffB); PG8_STAGE(PG8_SA(0, 0), a2, voffA);
            PG8_WAIT_V(8); PG8_WAIT_L(0); PG8_BAR; PG8_MMA(1, 0, At, B0); PG8_MMA(1, 1, At, B1); PG8_BAR; PG8_SCHED;
            PG8_LDB(B0, 1, 0); PG8_LDB(B1, 1, 1); PG8_SCHED; PG8_LDA(At, 1, 0); PG8_STAGE(PG8_SA(0, 1), a2 + hstep, voffA);
            PG8_WAIT_V(8); PG8_WAIT_L(0); PG8_BAR; PG8_MMA(0, 0, At, B0); PG8_MMA(0, 1, At, B1); PG8_BAR; PG8_SCHED;
            PG8_LDA(At, 1, 1); PG8_STAGE(PG8_SB(1, 0), b3, voffB); PG8_STAGE(PG8_SB(1, 1), b3 + hstep, voffB); PG8_STAGE(PG8_SA(1, 0), a3, voffA);
            PG8_WAIT_V(8); PG8_WAIT_L(0); PG8_BAR; PG8_MMA(1, 0, At, B0); PG8_MMA(1, 1, At, B1); PG8_BAR; PG8_SCHED;
            } else {
            PG8_LDB(B0, 0, 0); PG8_SCHED; PG8_LDA(At, 0, 0); PG8_STAGE(PG8_SA(1, 1), a1 + hstep, voffA);
            PG8_WAIT_L(8); PG8_BAR; PG8_WAIT_L(0); PG8_MMA(0, 0, At, B0); PG8_BAR; PG8_SCHED;
            PG8_LDB(B1, 0, 1); PG8_STAGE(PG8_SB(0, 0), b2, voffB);
            PG8_BAR; PG8_WAIT_L(0); PG8_MMA(0, 1, At, B1); PG8_BAR;
            PG8_LDA(At, 0, 1); PG8_STAGE(PG8_SA(0, 0), a2, voffA);
            PG8_BAR; PG8_WAIT_L(0); PG8_MMA(1, 0, At, B0); PG8_BAR; PG8_SCHED;
            PG8_STAGE(PG8_SB(0, 1), b2 + hstep, voffB);
            PG8_WAIT_V(6); PG8_BAR; PG8_MMA(1, 1, At, B1); PG8_BAR;
            PG8_LDB(B0, 1, 0); PG8_SCHED; PG8_LDA(At, 1, 0); PG8_STAGE(PG8_SA(0, 1), a2 + hstep, voffA);
            PG8_WAIT_L(8); PG8_BAR; PG8_WAIT_L(0); PG8_MMA(0, 0, At, B0); PG8_BAR; PG8_SCHED;
            PG8_LDB(B1, 1, 1); PG8_STAGE(PG8_SB(1, 0), b3, voffB);
            PG8_BAR; PG8_WAIT_L(0); PG8_MMA(0, 1, At, B1); PG8_BAR;
            PG8_LDA(At, 1, 1); PG8_STAGE(PG8_SA(1, 0), a3, voffA);
            PG8_BAR; PG8_WAIT_L(0); PG8_MMA(1, 0, At, B0); PG8_BAR; PG8_SCHED;
            PG8_STAGE(PG8_SB(1, 1), b3 + hstep, voffB);
            PG8_WAIT_V(6); PG8_BAR; PG8_MMA(1, 1, At, B1); PG8_BAR;
            }
        }
        if constexpr (ALIGN_EPI) { if (wr == 0) PG8_BAR; }
        if constexpr (!Epi::AFTER_DRAIN) { E(acc, cur, wr, wc, fr, fq); S.done(cur); }
        if (!has_next) break;
#pragma unroll
        for (int a = 0; a < 2; ++a)
#pragma unroll
            for (int b = 0; b < 2; ++b)
#pragma unroll
                for (int m = 0; m < 4; ++m)
#pragma unroll
                    for (int n = 0; n < 2; ++n) acc[a][b][m][n] = (f32x4){0.f, 0.f, 0.f, 0.f};
        cur = nxt; cA = nA; cB = nB; ++ui;
        if constexpr (ALIGN_EPI) { if (wr == 1) PG8_BAR; }
    }
    PG8_WAIT_V(0);
    if constexpr (!ALIGN_EPI) { if (wr == 0) PG8_BAR; }
    PG8_BAR;
    if constexpr (Epi::AFTER_DRAIN) { E.fused(acc, cur, wr, wc, fr, fq, lds, wid, lane); S.done(cur); }
#undef PG8_SA
#undef PG8_SB
#undef PG8_STAGE
#undef PG8_LDA
#undef PG8_LDB
#undef PG8_MMA
#undef PG8_WAIT_V
#undef PG8_WAIT_L
#undef PG8_BAR
#undef PG8_SCHED
}
}

#define XB_TMO      128
#define XB_XCNT(j)  (256  + 64 * (j))
#define XB_XSUB(j)  (1280 + 64 * (j))
#define XB_XGEN(j)  (2304 + 64 * (j))
#define XB_TOP      3328
#define XB_TOPGEN   3392
#define XCD_BAR_WORDS 3456
#define XB_SPIN_CAP (1u << 18)
#define LAS __attribute__((address_space(3)))

__device__ __forceinline__ unsigned xb_ld(unsigned* p)              { return __hip_atomic_load(p, __ATOMIC_RELAXED, __HIP_MEMORY_SCOPE_AGENT); }
__device__ __forceinline__ unsigned xb_add(unsigned* p, unsigned v) { return __hip_atomic_fetch_add(p, v, __ATOMIC_RELAXED, __HIP_MEMORY_SCOPE_AGENT); }
__device__ __forceinline__ unsigned xb_xcc_id() { return (unsigned)__builtin_amdgcn_s_getreg((3 << 11) | 20) & 0xFu; }
#define XB_SPIN(cond, bar) do { unsigned _sp = 0; while (cond) { __builtin_amdgcn_s_sleep(1); \
    if ((++_sp & 255u) == 0u) { if (xb_ld(&(bar)[XB_TMO])) break; if (_sp > XB_SPIN_CAP) { atomicAdd(&(bar)[XB_TMO], 1u); break; } } } } while (0)

struct XcdBarrier {
    unsigned* bar; unsigned x;
    volatile LAS unsigned* st;
};

__device__ __forceinline__ XcdBarrier xcd_barrier_post(unsigned* bar, volatile LAS unsigned* st) {
    XcdBarrier b; b.bar = bar; b.x = xb_xcc_id(); b.st = st;
    if (threadIdx.x == 0) (void)xb_add(&bar[XB_XCNT(b.x)], 1u);
    return b;
}
__device__ __forceinline__ void xcd_barrier_complete(unsigned* bar, unsigned x, unsigned& nloc, unsigned& nx) {
    const unsigned G = gridDim.x * gridDim.y * gridDim.z;
    unsigned sum, cnt, mine, sp = 0u;
    for (;;) {
        sum = 0u; cnt = 0u; mine = 0u;
#pragma unroll
        for (unsigned j = 0; j < 16; ++j) { const unsigned c = xb_ld(&bar[XB_XCNT(j)]); sum += c; cnt += (c > 0u) ? 1u : 0u; mine = (j == x) ? c : mine; }
        if (sum == G) break;
        __builtin_amdgcn_s_sleep(1);
        if ((++sp & 255u) == 0u) { if (xb_ld(&bar[XB_TMO])) break; if (sp > XB_SPIN_CAP) { atomicAdd(&bar[XB_TMO], 1u); break; } }
    }
    nloc = mine > 0u ? mine : 1u; nx = cnt > 0u ? cnt : 1u;
}

__device__ __forceinline__ void xcd_barrier(const XcdBarrier& b) {
    asm volatile("s_waitcnt vmcnt(0)" ::: "memory");
    __syncthreads();
    if (threadIdx.x == 0) {
        unsigned* bar = b.bar;
        __builtin_amdgcn_s_waitcnt(0);
        unsigned nloc = b.st[0], nx = b.st[1];
        if (nloc == 0u) { xcd_barrier_complete(bar, b.x, nloc, nx); b.st[0] = nloc; b.st[1] = nx; }
        const unsigned old = xb_add(&bar[XB_XSUB(b.x)], 1u);
        const unsigned gen = old / nloc;
        if (old + 1u == (gen + 1u) * nloc) {
            __builtin_amdgcn_fence(__ATOMIC_RELEASE, "agent");
            asm volatile("s_waitcnt vmcnt(0)" ::: "memory");
            const unsigned og = xb_add(&bar[XB_TOP], 1u);
            const unsigned tg = og / nx;
            if (og + 1u == (tg + 1u) * nx) xb_add(&bar[XB_TOPGEN], 1u);
            else XB_SPIN(xb_ld(&bar[XB_TOPGEN]) == tg, bar);
            __builtin_amdgcn_fence(__ATOMIC_ACQUIRE, "agent");
            xb_add(&bar[XB_XGEN(b.x)], 1u);
            asm volatile("s_waitcnt vmcnt(0)" ::: "memory");
        } else {
            XB_SPIN(xb_ld(&bar[XB_XGEN(b.x)]) == gen, bar);
            __builtin_amdgcn_fence(__ATOMIC_ACQUIRE, "agent");
            asm volatile("s_waitcnt vmcnt(0)" ::: "memory");
        }
    }
    __syncthreads();
}


using pg8::bf16_t; using pg8::bf16x8; using pg8::f32x4; using pg8::u32x4; using pg8::cvt_pk_bf16;
typedef unsigned u32x2 __attribute__((ext_vector_type(2)));
typedef float f32x2v __attribute__((ext_vector_type(2)));
constexpr int TP = 16384, TS = 512, T = TP + TS, DM = 1024, DFF = 2816, NIN = 3328, ZG = 2560  , NPH_L = 12, NLAYER = 4, NPHASES = NPH_L + (NPH_L - 1) * (NLAYER - 1) + 1;
constexpr float EPS = 1e-6f;
constexpr size_t W_F1IN = 0, W_F1OUT = W_F1IN + 5632ull * 1024, W_IN = W_F1OUT + 1024ull * 2816, W_OUT = W_IN + 3328ull * 1024, W_F2IN = W_OUT + 1024ull * 1024,
                 W_F2OUT = W_F2IN + 5632ull * 1024, W_GATE = W_F2OUT + 1024ull * 2816, W_PLE = W_GATE + 1024ull * 1024, W_TOTAL = W_PLE + 1024ull * 256;
constexpr size_t al256(size_t x) { return (x + 255) & ~(size_t)255; }
constexpr size_t WS_WT = 0  , WS_XN = al256(WS_WT + 2 * W_TOTAL * 2), WS_PB = al256(WS_XN + (size_t)T * DM * 2)  , WS_MIX = al256(WS_PB + 2 * (size_t)T * 256 * 2),
                 WS_F = al256(WS_MIX + (size_t)T * DM * 2), WS_ZL = al256(WS_F + (size_t)T * NIN * 2), WS_UB = al256(WS_ZL + (size_t)T * 8 * 4), WS_VNB = al256(WS_UB + (size_t)T * 512 * 2),
                 WS_OBUF = al256(WS_VNB + (size_t)T * 512 * 2), WS_Q16 = al256(WS_OBUF + (size_t)T * 512 * 4), WS_K16 = al256(WS_Q16 + (size_t)T * 512 * 2), WS_V16 = al256(WS_K16 + (size_t)T * 512 * 2),
                 WS_GB = al256(WS_V16 + (size_t)T * 512 * 2), WS_BETA = al256(WS_GB + (size_t)T * 4 * 4), WS_BTOT = al256(WS_BETA + (size_t)T * 4 * 4), WS_CHUNK = al256(WS_BTOT + 1024 * 4),
                 CHUNK_BYTES = 90112, CK_WT = 0, CK_NKB = 32768, CK_QB = 49152, CK_KENDT = 65536, CK_QKD = 81920, WS_ROWSS = al256(WS_CHUNK + 1024 * CHUNK_BYTES), WS_BAR = al256(WS_ROWSS + 16ull * T * 8), WS_STAMP = al256(WS_BAR + XCD_BAR_WORDS * 4), WS_END = al256(WS_STAMP + 4096);
constexpr size_t WS_PP = WS_CHUNK;
static_assert((size_t)T * DM * 4 <= 1024 * CHUNK_BYTES, "pp overlay");
constexpr size_t O_Y = 0, O_SP = (size_t)T * DM, O_CP = O_SP + 4ull * 8 * 4 * 128 * 128, O_SS = O_CP + 4ull * 8 * 3 * 1536, O_CS = O_SS + 4ull * 128 * 4 * 128 * 128, O_CV = O_CS + 4ull * 128 * 3 * 1536,
                 O_END = O_CV + 4ull * 128 * 4 * 4 * 128;
constexpr int LDS_BYTES = pg8::STAGE_BYTES + 16;

struct Params { const float* in[27]; float* out; unsigned char* ws; int ph_lo, ph_hi; };
struct Ctx { int tid, bid, nb; };
enum { I_XP = 0, I_XS, I_SS, I_SC, I_PP, I_PS, I_NF1, I_WF1I, I_WF1O, I_NMIX, I_WIN, I_AVG, I_ASW, I_ASB, I_AOG, I_BCW, I_BAL, I_BDT, I_BOG, I_WOUT, I_NF2, I_WF2I, I_WF2O, I_NPLE, I_WPG, I_WPP, I_FN };

__device__ __forceinline__ float bf2f(unsigned short b) { return __uint_as_float(((unsigned)b) << 16); }
__device__ __forceinline__ float bflo(unsigned w) { return __uint_as_float(w << 16); }
__device__ __forceinline__ float bfhi(unsigned w) { return __uint_as_float(w & 0xffff0000u); }
__device__ __forceinline__ void unpack8(const u32x4 w, float (&f)[8]) { f[0] = bflo(w.x); f[1] = bfhi(w.x); f[2] = bflo(w.y); f[3] = bfhi(w.y); f[4] = bflo(w.z); f[5] = bfhi(w.z); f[6] = bflo(w.w); f[7] = bfhi(w.w); }
__device__ __forceinline__ u32x4 pack8(const float (&f)[8]) { u32x4 w; w.x = cvt_pk_bf16(f[0], f[1]); w.y = cvt_pk_bf16(f[2], f[3]); w.z = cvt_pk_bf16(f[4], f[5]); w.w = cvt_pk_bf16(f[6], f[7]); return w; }
__device__ __forceinline__ float sigmoidf_(float x) { return __builtin_amdgcn_rcpf(1.0f + __expf(-x)); }
__device__ __forceinline__ float siluf_(float x) { return x * sigmoidf_(x); }
__device__ __forceinline__ float gelu_tanh(float x) { const float u = 0.7978845608028654f * (x + 0.044715f * x * x * x); return x * sigmoidf_(2.0f * u); }
__device__ __forceinline__ __amdgpu_buffer_rsrc_t wt_rsrc(void* base) { return __builtin_amdgcn_make_buffer_rsrc(base, 0, 0x7ffffff0, 0x00020000); }
__device__ __forceinline__ void st16_wt(const __amdgpu_buffer_rsrc_t r, size_t byte_off, u32x4 v) { __builtin_amdgcn_raw_buffer_store_b128(v, r, (unsigned)byte_off, 0,   16); }
__device__ __forceinline__ float red16(float v) { v += __shfl_xor(v, 1); v += __shfl_xor(v, 2); v += __shfl_xor(v, 4); v += __shfl_xor(v, 8); return v; }
__device__ __forceinline__ float red64(float v) { v = red16(v); v += __shfl_xor(v, 16); v += __shfl_xor(v, 32); return v; }

typedef unsigned long long u64;
constexpr float RS_FIX = 1048576.0f, RS_INV = 1.0f / (1048576.0f * 1024.0f);
__device__ __forceinline__ float rstd_of(u64 v) { return rsqrtf((float)(long long)v * RS_INV + EPS); }
__device__ __forceinline__ void load_rstd(const u64* RS, int row0, float (&rs)[2][4]) {
#pragma unroll
    for (int ai = 0; ai < 2; ++ai)
#pragma unroll
        for (int m = 0; m < 4; ++m) rs[ai][m] = rstd_of(RS[row0 + ai * 128 + m * 16]);
}
struct EpiSwiGLU {
    static constexpr bool PERM = true, AFTER_DRAIN = false, ALIGN = true;
    bf16_t* H; const u64* RS;
    __device__ __forceinline__ void operator()(const f32x4 (&acc)[2][2][4][2], const pg8::Unit& u, int wr, int wc, int fr, int fq) const {
        const int row0 = u.pm * 256 + wr * 64 + fr, col0 = u.pn * 128 + wc * 32 + 8 * fq;
        float rs[2][4]; load_rstd(RS, row0, rs);
        const __amdgpu_buffer_rsrc_t hr = wt_rsrc(H);
#pragma unroll
        for (int ai = 0; ai < 2; ++ai)
#pragma unroll
            for (int m = 0; m < 4; ++m) {
                float o[8];
#pragma unroll
                for (int n = 0; n < 2; ++n)
#pragma unroll
                    for (int j = 0; j < 4; ++j) o[n * 4 + j] = siluf_(acc[ai][0][m][n][j] * rs[ai][m]) * (acc[ai][1][m][n][j] * rs[ai][m]);
                st16_wt(hr, ((size_t)(row0 + ai * 128 + m * 16) * DFF + col0) * 2, pack8(o));
            }
    }
};
template <bool GATE> struct EpiResidT {
    static constexpr bool PERM = true, AFTER_DRAIN = true, ALIGN = false;
    static constexpr int MB = 4;
    const bf16_t* XS; bf16_t* XD; u64* RSO; float scale; const bf16_t* PP; const u64* RS;
    __device__ __forceinline__ void fused(const f32x4 (&acc)[2][2][4][2], const pg8::Unit& u, int wr, int wc, int fr, int fq, PG8_LAS unsigned char* lds, int wid, int lane) const {
        PG8_LAS float* P = (PG8_LAS float*)lds;
        const int row0 = u.pm * 256 + wr * 64 + fr, col0 = u.pn * 256 + wc * 32 + 8 * fq;
        const __amdgpu_buffer_rsrc_t xr = wt_rsrc(XD);
#pragma unroll
        for (int ai = 0; ai < 2; ++ai)
#pragma unroll
            for (int mh = 0; mh < 4; mh += MB) {
                u32x4 t[MB][2], pp[MB][2]; u64 rs[MB];
#pragma unroll
                for (int m = 0; m < MB; ++m) {
                    if (GATE) rs[m] = RS[row0 + ai * 128 + (mh + m) * 16];
#pragma unroll
                    for (int bj = 0; bj < 2; ++bj) { const size_t o = (size_t)(row0 + ai * 128 + (mh + m) * 16) * DM + col0 + bj * 128; t[m][bj] = __builtin_nontemporal_load((const u32x4*)(XS + o)); if (GATE) pp[m][bj] = __builtin_nontemporal_load((const u32x4*)(PP + o)); }
                }
#pragma unroll
                for (int m = 0; m < MB; ++m) {
                    const int row = row0 + ai * 128 + (mh + m) * 16; float ss = 0.f;
                    const float r = GATE ? rstd_of(rs[m]) : 0.f;
#pragma unroll
                    for (int bj = 0; bj < 2; ++bj) { const size_t o = (size_t)row * DM + col0 + bj * 128;
                        float x[8]; unpack8(t[m][bj], x);
                        if (GATE) { float q[8]; unpack8(pp[m][bj], q);
#pragma unroll
                            for (int e = 0; e < 8; ++e) x[e] += q[e] * sigmoidf_(acc[ai][bj][mh + m][e >> 2][e & 3] * r); }
                        else {
#pragma unroll
                            for (int e = 0; e < 8; ++e) x[e] += acc[ai][bj][mh + m][e >> 2][e & 3] * scale; }
                        const u32x4 w = pack8(x); st16_wt(xr, o * 2, w);
                        float y[8]; unpack8(w, y);
#pragma unroll
                        for (int e = 0; e < 8; ++e) ss += y[e] * y[e]; }
                    ss += __shfl_xor(ss, 16); ss += __shfl_xor(ss, 32); if (fq == 0) P[(row - u.pm * 256) * 4 + wc] = ss;
                }
            }
        __syncthreads();
        const int tl = wid * 64 + lane;
        if (RSO && tl < 256) { const float sum = (P[tl * 4 + 0] + P[tl * 4 + 1]) + (P[tl * 4 + 2] + P[tl * 4 + 3]); atomicAdd(RSO + u.pm * 256 + tl, (u64)(long long)(sum * RS_FIX)); }
        __syncthreads();
    }
};
struct EpiZ {
    static constexpr bool PERM = true, AFTER_DRAIN = false, ALIGN = true;
    bf16_t* Z; float* ZL; const u64* RS;
    __device__ __forceinline__ void operator()(const f32x4 (&acc)[2][2][4][2], const pg8::Unit& u, int wr, int wc, int fr, int fq) const {
        const int row0 = u.pm * 256 + wr * 64 + fr;
        float rs[2][4]; load_rstd(RS, row0, rs);
        if (u.pn == 12) {
            if (wc == 0 && fq == 0) {
#pragma unroll
                for (int ai = 0; ai < 2; ++ai)
#pragma unroll
                    for (int m = 0; m < 4; ++m) { float* q = ZL + (size_t)(row0 + ai * 128 + m * 16) * 8; *(f32x4*)q = acc[ai][0][m][0] * rs[ai][m]; *(f32x4*)(q + 4) = acc[ai][0][m][1] * rs[ai][m]; }
            }
            return;
        }
        const int col0 = u.pn * 256 + wc * 32 + 8 * fq; const __amdgpu_buffer_rsrc_t zr_ = wt_rsrc(Z);
#pragma unroll
        for (int ai = 0; ai < 2; ++ai)
#pragma unroll
            for (int m = 0; m < 4; ++m) { const size_t rowo = ((size_t)(row0 + ai * 128 + m * 16) * NIN + col0) * 2; const float r = rs[ai][m];
#pragma unroll
                for (int bj = 0; bj < 2; ++bj) { const f32x4 v0 = acc[ai][bj][m][0] * r, v1 = acc[ai][bj][m][1] * r;
                    u32x4 w; w.x = cvt_pk_bf16(v0[0], v0[1]); w.y = cvt_pk_bf16(v0[2], v0[3]); w.z = cvt_pk_bf16(v1[0], v1[1]); w.w = cvt_pk_bf16(v1[2], v1[3]);
                    st16_wt(zr_, rowo + bj * 256, w); } }
    }
};
struct EpiStoreBf16 {
    static constexpr bool PERM = true, AFTER_DRAIN = false, ALIGN = false;
    bf16_t* C;
    __device__ __forceinline__ void operator()(const f32x4 (&acc)[2][2][4][2], const pg8::Unit& u, int wr, int wc, int fr, int fq) const {
        const int row0 = u.pm * 256 + wr * 64 + fr, col0 = u.pn * 256 + wc * 32 + 8 * fq; const __amdgpu_buffer_rsrc_t cr = wt_rsrc(C);
#pragma unroll
        for (int ai = 0; ai < 2; ++ai)
#pragma unroll
            for (int m = 0; m < 4; ++m) { const size_t rowo = (size_t)(row0 + ai * 128 + m * 16) * DM + col0;
#pragma unroll
                for (int bj = 0; bj < 2; ++bj) { const f32x4 v0 = acc[ai][bj][m][0], v1 = acc[ai][bj][m][1];
                    u32x4 w; w.x = cvt_pk_bf16(v0[0], v0[1]); w.y = cvt_pk_bf16(v0[2], v0[3]); w.z = cvt_pk_bf16(v1[0], v1[1]); w.w = cvt_pk_bf16(v1[2], v1[3]);
                    st16_wt(cr, (rowo + bj * 128) * 2, w); } }
    }
};
template <class Epi> __device__ __forceinline__ void run_gemm(PG8_LAS unsigned char* lds, const bf16_t* A, const bf16_t* Bt, int N, int K, const Epi& E, const Ctx& cx, int M = T) {
    pg8::Gemm g; g.A = A; g.Bt = Bt; g.M = M; g.N = N; g.K = K;
    pg8::StaticOrder S; S.init(M, N, cx.nb, cx.bid);
    pg8::gemm_phase<Epi, pg8::StaticOrder, (MK_ALIGN && Epi::ALIGN), MK_SP2>(lds, g, S, E, cx.tid);
}

template <int MODE, class EP> __device__ __forceinline__ void mini_gemm_sample(const bf16_t* A, const bf16_t* Bt, int K, const EP& E, const Ctx& cx, unsigned char* shm) {
    const int tid = cx.tid, wv = __builtin_amdgcn_readfirstlane(tid >> 6), lane = tid & 63, fr = lane & 15, fq = lane >> 4;
    constexpr int STG = 96 * 256;
    const int ns = K >> 7;
    int srow[3], sdst[3]; bool sisA[3];
#pragma unroll
    for (int i = 0; i < 3; ++i) { const int g = tid + 512 * i, c = g & 15; sisA[i] = g < 512; srow[i] = sisA[i] ? (g >> 4) : ((g - 512) >> 4);
        sdst[i] = (sisA[i] ? 0 : 32 * 256) + srow[i] * 256 + ((c ^ (srow[i] & 15)) << 4); }
    const int cch = (tid & 15) * 8;
    for (int blk = cx.bid; blk < 256; blk += cx.nb) {
        const int rbase = TP + (blk >> 4) * 32, cbase = (blk & 15) * 64;
        const bf16_t* gsrc[3];
#pragma unroll
        for (int i = 0; i < 3; ++i) gsrc[i] = (sisA[i] ? A + (size_t)(rbase + srow[i]) * K : Bt + (size_t)(cbase + srow[i]) * K) + cch;
        u32x4 R0[3], R1[3];
#pragma unroll
        for (int i = 0; i < 3; ++i) { R0[i] = *(const u32x4*)(gsrc[i]); R1[i] = *(const u32x4*)(gsrc[i] + 128); }
        __syncthreads();
#pragma unroll
        for (int i = 0; i < 3; ++i) *(u32x4*)(shm + sdst[i]) = R0[i];
        __syncthreads();
        f32x4 acc0 = (f32x4){0.f, 0.f, 0.f, 0.f}, acc1 = acc0;
        const int arow = (wv >> 2) * 16 + fr, brow = (wv & 3) * 16 + fr;
        const int aoff = arow * 256, boff = 32 * 256 + brow * 256, asw = arow & 15, bsw = brow & 15;
#define MINI_COMPUTE(stage) do { const unsigned char* sb_ = shm + (stage) * STG; \
            _Pragma("unroll") for (int ks = 0; ks < 4; ks += 2) { \
                const bf16x8 a0_ = *(const bf16x8*)(sb_ + aoff + (((ks * 4 + fq) ^ asw) << 4)), b0_ = *(const bf16x8*)(sb_ + boff + (((ks * 4 + fq) ^ bsw) << 4)); \
                const bf16x8 a1_ = *(const bf16x8*)(sb_ + aoff + ((((ks + 1) * 4 + fq) ^ asw) << 4)), b1_ = *(const bf16x8*)(sb_ + boff + ((((ks + 1) * 4 + fq) ^ bsw) << 4)); \
                acc0 = __builtin_amdgcn_mfma_f32_16x16x32_bf16(b0_, a0_, acc0, 0, 0, 0); acc1 = __builtin_amdgcn_mfma_f32_16x16x32_bf16(b1_, a1_, acc1, 0, 0, 0); } } while (0)
        for (int sl = 0; sl < ns; sl += 2) {
            if (sl + 2 < ns) {
#pragma unroll
                for (int i = 0; i < 3; ++i) R0[i] = *(const u32x4*)(gsrc[i] + (size_t)(sl + 2) * 128); }
            MINI_COMPUTE(0);
#pragma unroll
            for (int i = 0; i < 3; ++i) *(u32x4*)(shm + STG + sdst[i]) = R1[i];
            __syncthreads();
            if (sl + 3 < ns) {
#pragma unroll
                for (int i = 0; i < 3; ++i) R1[i] = *(const u32x4*)(gsrc[i] + (size_t)(sl + 3) * 128); }
            MINI_COMPUTE(1);
            if (sl + 2 < ns) {
#pragma unroll
                for (int i = 0; i < 3; ++i) *(u32x4*)(shm + sdst[i]) = R0[i]; }
            __syncthreads();
        }
#undef MINI_COMPUTE
        const f32x4 a = acc0 + acc1;
        const int row0 = rbase + (wv >> 2) * 16, col0 = cbase + (wv & 3) * 16;
        const int row = row0 + fr; const size_t o = (size_t)row * DM + col0 + fq * 4;
        if constexpr (MODE == 2) { u32x2 w; w.x = cvt_pk_bf16(a[0], a[1]); w.y = cvt_pk_bf16(a[2], a[3]); *(u32x2*)(E.XD + o) = w; }
        else {
            const u32x2 tw = *(const u32x2*)(E.XS + o); f32x4 x = (f32x4){bflo(tw.x), bfhi(tw.x), bflo(tw.y), bfhi(tw.y)};
            if constexpr (MODE == 1) { const float r = rstd_of(E.RS[row]); const u32x2 qw = *(const u32x2*)(E.PP + o); const f32x4 q = (f32x4){bflo(qw.x), bfhi(qw.x), bflo(qw.y), bfhi(qw.y)};
                x[0] += q[0] * sigmoidf_(a[0] * r); x[1] += q[1] * sigmoidf_(a[1] * r); x[2] += q[2] * sigmoidf_(a[2] * r); x[3] += q[3] * sigmoidf_(a[3] * r); }
            else x = x + a * E.scale;
            u32x2 w; w.x = cvt_pk_bf16(x[0], x[1]); w.y = cvt_pk_bf16(x[2], x[3]); *(u32x2*)(E.XD + o) = w;
            if (E.RSO) { const float y0 = bflo(w.x), y1 = bfhi(w.x), y2 = bflo(w.y), y3 = bfhi(w.y); float ss = y0 * y0 + y1 * y1 + y2 * y2 + y3 * y3; ss += __shfl_xor(ss, 16); ss += __shfl_xor(ss, 32); if (fq == 0) atomicAdd(E.RSO + row, (u64)(long long)(ss * RS_FIX)); }
        }
    }
}

__device__ __forceinline__ int src_col(int map, int n) {
    if (map == 0) return n;
    if (map == 1) { const int pn = n >> 8, w = n & 255; return (w < 128) ? (pn * 128 + w) : (DFF + pn * 128 + (w - 128)); }
    if (n < 2560) return n;
    if (n < 3072) return n + 8;
    if (n < 3080) return 2560 + (n - 3072);
    return -1;
}
struct CvtItem { float v[32]; bf16_t* dp; const float* gn; int k0; bool zero; };
__device__ __forceinline__ void cvt_load(const Params& p, int l, int it, int lane, CvtItem& c) {
    bf16_t* wt = (bf16_t*)(p.ws + WS_WT) + (size_t)(l & 1) * W_TOTAL;
    const float* src; const float* gn = nullptr; int K, pitch, map, lt; bf16_t* dst;
    if (it < 2816)       { lt = it;         src = p.in[I_WF1I] + (size_t)l * 1024 * 5632; K = 1024; pitch = 5632; map = 1; dst = wt + W_F1IN; gn = p.in[I_NF1] + l * 1024; }
    else if (it < 4224)  { lt = it - 2816;  src = p.in[I_WF1O] + (size_t)l * 2816 * 1024; K = 2816; pitch = 1024; map = 0; dst = wt + W_F1OUT; }
    else if (it < 5888)  { lt = it - 4224;  src = p.in[I_WIN] + (size_t)l * 1024 * 3080;  K = 1024; pitch = 3080; map = 2; dst = wt + W_IN; gn = p.in[I_NMIX] + l * 1024; }
    else if (it < 6400)  { lt = it - 5888;  src = p.in[I_WOUT] + (size_t)l * 1024 * 1024; K = 1024; pitch = 1024; map = 0; dst = wt + W_OUT; }
    else if (it < 9216)  { lt = it - 6400;  src = p.in[I_WF2I] + (size_t)l * 1024 * 5632; K = 1024; pitch = 5632; map = 1; dst = wt + W_F2IN; gn = p.in[I_NF2] + l * 1024; }
    else if (it < 10624) { lt = it - 9216;  src = p.in[I_WF2O] + (size_t)l * 2816 * 1024; K = 2816; pitch = 1024; map = 0; dst = wt + W_F2OUT; }
    else if (it < 11136) { lt = it - 10624; src = p.in[I_WPG] + (size_t)l * 1024 * 1024;  K = 1024; pitch = 1024; map = 0; dst = wt + W_GATE; gn = p.in[I_NPLE] + l * 1024; }
    else                 { lt = it - 11136; src = p.in[I_WPP] + (size_t)l * 256 * 1024;   K = 256;  pitch = 1024; map = 0; dst = wt + W_PLE; }
    const int nkb = K >> 5, nb_ = lt / nkb, kb = lt - nb_ * nkb, n = nb_ * 64 + lane, k0 = kb * 32;
    int sc = src_col(map, n & ~3); if (sc >= 0) sc += (n & 3);
    const float* sp = src + (size_t)k0 * pitch + (sc >= 0 ? sc : 0);
#pragma unroll
    for (int j = 0; j < 32; ++j) c.v[j] = __builtin_nontemporal_load(sp + (size_t)j * pitch);
    c.dp = dst + (size_t)n * K + k0; c.gn = gn; c.k0 = k0; c.zero = sc < 0;
}
__device__ __forceinline__ void cvt_store(CvtItem& c) {
    if (c.zero) {
#pragma unroll
        for (int j = 0; j < 32; ++j) c.v[j] = 0.f; }
    if (c.gn) {
#pragma unroll
        for (int j = 0; j < 32; ++j) c.v[j] *= c.gn[c.k0 + j]; }
#pragma unroll
    for (int q = 0; q < 4; ++q) { u32x4 w; w.x = cvt_pk_bf16(c.v[q * 8], c.v[q * 8 + 1]); w.y = cvt_pk_bf16(c.v[q * 8 + 2], c.v[q * 8 + 3]); w.z = cvt_pk_bf16(c.v[q * 8 + 4], c.v[q * 8 + 5]); w.w = cvt_pk_bf16(c.v[q * 8 + 6], c.v[q * 8 + 7]); *(u32x4*)(c.dp + q * 8) = w; }
}
constexpr int CVT_ITEMS = 11264;
__device__ __forceinline__ void convert_p(const Params& p, int l, const Ctx& cx) {
    bf16_t* pb = (bf16_t*)(p.ws + WS_PB) + (size_t)(l & 1) * T * 256;
    for (int i = cx.bid * 512 + cx.tid; i < T * 32; i += cx.nb * 512) {
        const int row = i >> 5, c8 = (i & 31) * 8;
        const float* s = (row < TP) ? p.in[I_PP] + ((size_t)l * TP + row) * 256 + c8 : p.in[I_PS] + ((size_t)l * TS + (row - TP)) * 256 + c8;
        const f32x4 a = __builtin_nontemporal_load((const f32x4*)s), b = __builtin_nontemporal_load((const f32x4*)(s + 4));
        u32x4 w; w.x = cvt_pk_bf16(a[0], a[1]); w.y = cvt_pk_bf16(a[2], a[3]); w.z = cvt_pk_bf16(b[0], b[1]); w.w = cvt_pk_bf16(b[2], b[3]);
        *(u32x4*)(pb + (size_t)row * 256 + c8) = w;
    }
}
__device__ void phase_convert(const Params& p, int l, unsigned char* shm, const Ctx& cx) {
    const int wv = __builtin_amdgcn_readfirstlane(cx.tid >> 6), lane = cx.tid & 63;
    for (int it = cx.bid * 8 + wv; it < CVT_ITEMS; it += cx.nb * 8) { CvtItem c; cvt_load(p, l, it, lane, c); cvt_store(c); }
    convert_p(p, l, cx);
}

__device__ void phase_norm(const Params& p, const float* gain, bool first, bool final_, const Ctx& cx) {
    const int tid = cx.tid, wid = tid >> 6, lane = tid & 63;
    bf16_t* xb = (bf16_t*)(p.ws + WS_XN); const bf16_t* xl = (const bf16_t*)(p.ws + WS_MIX); u64* rowss = (u64*)(p.ws + WS_ROWSS);
    if (first) { for (int i = cx.bid * 512 + tid; i < 15 * T / 2; i += cx.nb * 512) ((f32x4*)(rowss + T))[i] = (f32x4){0.f, 0.f, 0.f, 0.f}; }
    f32x4 g[4];
#pragma unroll
    for (int i = 0; i < 4; ++i) g[i] = final_ ? *(const f32x4*)(gain + i * 256 + lane * 4) : (f32x4){1.f, 1.f, 1.f, 1.f};
    for (int row = cx.bid * 8 + wid; row < T; row += cx.nb * 8) {
        f32x4 v[4]; float ss = 0.f;
#pragma unroll
        for (int i = 0; i < 4; ++i) {
            if (first) { const float* s = (row < TP) ? p.in[I_XP] + (size_t)row * DM : p.in[I_XS] + (size_t)(row - TP) * DM; const f32x4 f = *(const f32x4*)(s + i * 256 + lane * 4);
                u32x2 w; w.x = cvt_pk_bf16(f[0], f[1]); w.y = cvt_pk_bf16(f[2], f[3]); *(u32x2*)(xb + (size_t)row * DM + i * 256 + lane * 4) = w;
                v[i] = (f32x4){bflo(w.x), bfhi(w.x), bflo(w.y), bfhi(w.y)}; }
            else { const u32x2 w = *(const u32x2*)(xl + (size_t)row * DM + i * 256 + lane * 4); v[i] = (f32x4){bflo(w.x), bfhi(w.x), bflo(w.y), bfhi(w.y)}; }
            ss += v[i][0] * v[i][0] + v[i][1] * v[i][1] + v[i][2] * v[i][2] + v[i][3] * v[i][3];
        }
        ss = red64(ss);
        const float r = rsqrtf(ss * (1.0f / 1024.0f) + EPS);
        if (first && lane == 0) rowss[row] = (u64)(long long)(ss * RS_FIX);
        if (final_) {
#pragma unroll
            for (int i = 0; i < 4; ++i) { f32x4 y = v[i] * r * g[i];
#if MK_TIME
                if (row == TP && lane == 0 && i == 0) {
                    const unsigned long long* st = (const unsigned long long*)(p.ws + WS_STAMP);
                    float w[12]; float bar = 0.f;
#pragma unroll
                    for (int k = 0; k < 12; ++k) w[k] = 0.f;
                    for (int ph = 0; ph < NPHASES - 1; ++ph) { const int s_ = ph < NPH_L ? ph : 1 + (ph - NPH_L) % (NPH_L - 1); const float d = (float)(long long)(st[2 * ph + 1] - st[2 * ph]) * 0.01f;
                        const float b = (float)(long long)(st[2 * ph + 2] - st[2 * ph + 1]) * 0.01f; bar += b;
#pragma unroll
                        for (int k = 0; k < 12; ++k) if (k == s_) w[k] += d; }
                    float n0, n1, n2;
                    if (MK_TIME == 1) { n0 = (w[1] + w[9]) * 0.05f; n1 = (w[2] + w[10]) * 0.1f; n2 = w[3] * 0.1f; }
                    else if (MK_TIME == 2) { n0 = w[4] * 0.1f; n1 = w[5] * 0.1f; n2 = w[6] * 0.1f; }
                    else if (MK_TIME == 3) { n0 = w[7] * 0.1f; n1 = (w[8] + w[11]) * 0.1f; n2 = bar * 0.05f; }
                    else if (MK_TIME == 4) { n0 = (w[2] + w[10]) * 0.1f; n1 = 0.f; n2 = 0.f; }
                    else if (MK_TIME == 5) { n0 = w[5] * 0.1f; n1 = 0.f; n2 = 0.f; }
                    else if (MK_TIME == 6) { n0 = w[6] * 0.1f; n1 = 0.f; n2 = 0.f; }
                    else if (MK_TIME == 7) { n0 = (w[8] + w[11]) * 0.1f; n1 = 0.f; n2 = 0.f; }
                    else if (MK_TIME == 8) { n0 = bar * 0.05f; n1 = 0.f; n2 = 0.f; }
                    else if (MK_TIME == 9) { n0 = w[3] * 0.1f; n1 = 0.f; n2 = 0.f; }
                    else if (MK_TIME == 10) { n0 = w[0] * 0.1f; n1 = 0.f; n2 = 0.f; }
                    else if (MK_TIME == 14) { n0 = (float)(long long)st[200] * 0.01f * 0.1f; n1 = 0.f; n2 = 0.f; }
                    else { n0 = 0.f; n1 = 0.f; n2 = 0.f; }
                    const int c0_ = min(99, (int)(n0 + 0.5f)), c1_ = min(99, (int)(n1 + 0.5f)), c2_ = min(99, (int)(n2 + 0.5f));
                    int P = c0_ * 10000 + c1_ * 100 + c2_;
                    if (MK_TIME == 11) P = 125000; if (MK_TIME == 12) P = 500000; if (MK_TIME == 13) P = 875000;
                    y[0] = 9.0f + 8.0f * (float)P * 1e-6f;
                }
#endif
                *(f32x4*)(p.out + O_Y + (size_t)row * DM + i * 256 + lane * 4) = y; }
        }
    }
}

struct PRaw { u32x4 zu, zv, pr[4][3]; float a4, b4; };
__device__ __forceinline__ void pi_load(const bf16_t* z, const float* zl, int t, int c0, int lane, PRaw& R) {
    const bf16_t* zr = z + (size_t)t * NIN; R.zu = *(const u32x4*)(zr + c0); R.zv = *(const u32x4*)(zr + 512 + c0);
    const int pos = t & 2047;
#pragma unroll
    for (int j = 0; j < 4; ++j) { const int tr = (pos - 3 + j >= 0) ? t - 3 + j : t;
#pragma unroll
        for (int grp = 0; grp < 3; ++grp) R.pr[j][grp] = *(const u32x4*)(z + (size_t)tr * NIN + 1024 + grp * 512 + c0); }
    R.a4 = zl[(size_t)t * 8 + (lane & 3)]; R.b4 = zl[(size_t)t * 8 + 4 + (lane & 3)];
}
__device__ __forceinline__ void pi_compute(const Params& p, int l, int t, int c0, int lane, const PRaw& R, const float (&gv)[8], const float* cw, float* cpo) {
    bf16_t* ub = (bf16_t*)(p.ws + WS_UB); bf16_t* vnb = (bf16_t*)(p.ws + WS_VNB);
    bf16_t* q16 = (bf16_t*)(p.ws + WS_Q16); bf16_t* k16 = (bf16_t*)(p.ws + WS_K16); bf16_t* v16 = (bf16_t*)(p.ws + WS_V16);
    float* gb = (float*)(p.ws + WS_GB); float* betab = (float*)(p.ws + WS_BETA);
    const int b = t >> 11, pos = t & 2047;
    float f[8], o[8];
    unpack8(R.zu, f);
#pragma unroll
    for (int e = 0; e < 8; ++e) o[e] = gelu_tanh(f[e]);
    st16_wt(wt_rsrc(ub), ((size_t)t * 512 + c0) * 2, pack8(o));
    unpack8(R.zv, f);
    float ss = 0.f;
#pragma unroll
    for (int e = 0; e < 8; ++e) { f[e] = gelu_tanh(f[e]); ss += f[e] * f[e]; }
    ss = red16(ss);
    { const float r = rsqrtf(ss * (1.0f / 128.0f) + EPS);
#pragma unroll
      for (int e = 0; e < 8; ++e) o[e] = f[e] * r * gv[e]; }
    st16_wt(wt_rsrc(vnb), ((size_t)t * 512 + c0) * 2, pack8(o));
#pragma unroll
    for (int grp = 0; grp < 3; ++grp) {
        const int ch = grp * 512 + c0;
        float y[8];
#pragma unroll
        for (int e = 0; e < 8; ++e) y[e] = 0.f;
#pragma unroll
        for (int j = 0; j < 4; ++j) {
            float pre[8]; unpack8(R.pr[j][grp], pre);
            const float msk = (pos - 3 + j >= 0) ? 1.0f : 0.0f;
            const f32x4 w0 = *(const f32x4*)(cw + j * 1536 + ch) * msk, w1 = *(const f32x4*)(cw + j * 1536 + ch + 4) * msk;
            y[0] += pre[0] * w0[0]; y[1] += pre[1] * w0[1]; y[2] += pre[2] * w0[2]; y[3] += pre[3] * w0[3];
            y[4] += pre[4] * w1[0]; y[5] += pre[5] * w1[1]; y[6] += pre[6] * w1[2]; y[7] += pre[7] * w1[3];
            if (j == 3 && pos >= 2045) { float* dst = cpo + ((size_t)b * 3 + (pos - 2045)) * 1536 + ch;
                *(f32x4*)dst = (f32x4){pre[0], pre[1], pre[2], pre[3]}; *(f32x4*)(dst + 4) = (f32x4){pre[4], pre[5], pre[6], pre[7]}; }
        }
        float s2 = 0.f;
#pragma unroll
        for (int e = 0; e < 8; ++e) { y[e] = siluf_(y[e]); s2 += y[e] * y[e]; }
        if (grp < 2) {
            s2 = red16(s2);
            const float r = rsqrtf(s2 + EPS) * (grp == 0 ? 0.08838834764831845f : 1.0f);
#pragma unroll
            for (int e = 0; e < 8; ++e) y[e] *= r;
        }
        st16_wt(wt_rsrc(grp == 0 ? q16 : (grp == 1 ? k16 : v16)), ((size_t)t * 512 + c0) * 2, pack8(y));
    }
    if (lane < 4) {
        const float a = R.a4 + p.in[I_BDT][l * 4 + lane];
        const float sp = (a > 20.f) ? a : log1pf(__expf(a));
        gb[(size_t)t * 4 + lane] = -__expf(p.in[I_BAL][l * 4 + lane]) * sp;
        betab[(size_t)t * 4 + lane] = sigmoidf_(R.b4);
    }
}
__device__ void phase_postin(const Params& p, int l, const Ctx& cx) {
    const int tid = cx.tid, wid = tid >> 6, lane = tid & 63, c0 = lane * 8, hd = lane >> 4, cd = c0 & 127;
    const bf16_t* z = (const bf16_t*)(p.ws + WS_F); const float* zl = (const float*)(p.ws + WS_ZL);
    bf16_t* ub = (bf16_t*)(p.ws + WS_UB); bf16_t* vnb = (bf16_t*)(p.ws + WS_VNB);
    bf16_t* q16 = (bf16_t*)(p.ws + WS_Q16); bf16_t* k16 = (bf16_t*)(p.ws + WS_K16); bf16_t* v16 = (bf16_t*)(p.ws + WS_V16);
    float* gb = (float*)(p.ws + WS_GB); float* betab = (float*)(p.ws + WS_BETA);
    const float* avg = p.in[I_AVG] + l * 128; const float* cw = p.in[I_BCW] + (size_t)l * 4 * 1536;
    const float* sc = p.in[I_SC] + (size_t)l * 128 * 3 * 1536;
    float* cpo = p.out + O_CP + (size_t)l * 8 * 3 * 1536; float* cso = p.out + O_CS + (size_t)l * 128 * 3 * 1536; float* cvo = p.out + O_CV + (size_t)l * TS * 512;
    float gv[8];
#pragma unroll
    for (int e = 0; e < 8; ++e) gv[e] = avg[cd + e];
    {
        const int stride = cx.nb * 8; int t = cx.bid * 8 + wid;
        if (t < TP) {
            PRaw R0, R1; pi_load(z, zl, t, c0, lane, R0);
            for (;;) {
                const int t1 = t + stride; const bool h1 = t1 < TP; pi_load(z, zl, h1 ? t1 : t, c0, lane, R1); pi_compute(p, l, t, c0, lane, R0, gv, cw, cpo); if (!h1) break;
                const int t2 = t1 + stride; const bool h2 = t2 < TP; pi_load(z, zl, h2 ? t2 : t1, c0, lane, R0); pi_compute(p, l, t1, c0, lane, R1, gv, cw, cpo); if (!h2) break;
                t = t2;
            }
        }
    }
    for (int t = TP + cx.bid * 8 + wid; t < T; t += cx.nb * 8) {
        const bool prompt = t < TP; const int b = prompt ? (t >> 11) : ((t - TP) >> 2), pos = prompt ? (t & 2047) : ((t - TP) & 3);
        const bf16_t* zr = z + (size_t)t * NIN;
        float f[8], o[8];
        unpack8(*(const u32x4*)(zr + c0), f);
#pragma unroll
        for (int e = 0; e < 8; ++e) o[e] = gelu_tanh(f[e]);
        *(u32x4*)(ub + (size_t)t * 512 + c0) = pack8(o);
        unpack8(*(const u32x4*)(zr + 512 + c0), f);
        float ss = 0.f;
#pragma unroll
        for (int e = 0; e < 8; ++e) { f[e] = gelu_tanh(f[e]); ss += f[e] * f[e]; }
        ss = red16(ss);
        { const float r = rsqrtf(ss * (1.0f / 128.0f) + EPS);
#pragma unroll
          for (int e = 0; e < 8; ++e) o[e] = f[e] * r * gv[e]; }
        *(u32x4*)(vnb + (size_t)t * 512 + c0) = pack8(o);
        if (!prompt) { float* q = cvo + (size_t)(t - TP) * 512 + c0; *(f32x4*)q = (f32x4){o[0], o[1], o[2], o[3]}; *(f32x4*)(q + 4) = (f32x4){o[4], o[5], o[6], o[7]}; }
#pragma unroll
        for (int grp = 0; grp < 3; ++grp) {
            const int ch = grp * 512 + c0;
            float y[8];
#pragma unroll
            for (int e = 0; e < 8; ++e) y[e] = 0.f;
#pragma unroll
            for (int j = 0; j < 4; ++j) {
                const int rp = pos - 3 + j;
                float pre[8];
                if (rp >= 0) unpack8(*(const u32x4*)(z + (size_t)(t - 3 + j) * NIN + 1024 + ch), pre);
                else if (!prompt) { const float* s = sc + ((size_t)b * 3 + (rp + 3)) * 1536 + ch; const f32x4 a = *(const f32x4*)s, bq = *(const f32x4*)(s + 4);
                    pre[0] = a[0]; pre[1] = a[1]; pre[2] = a[2]; pre[3] = a[3]; pre[4] = bq[0]; pre[5] = bq[1]; pre[6] = bq[2]; pre[7] = bq[3]; }
                else {
#pragma unroll
                    for (int e = 0; e < 8; ++e) pre[e] = 0.f; }
                const f32x4 w0 = *(const f32x4*)(cw + j * 1536 + ch), w1 = *(const f32x4*)(cw + j * 1536 + ch + 4);
                y[0] += pre[0] * w0[0]; y[1] += pre[1] * w0[1]; y[2] += pre[2] * w0[2]; y[3] += pre[3] * w0[3];
                y[4] += pre[4] * w1[0]; y[5] += pre[5] * w1[1]; y[6] += pre[6] * w1[2]; y[7] += pre[7] * w1[3];
                if (j == 3) {
                    float* dst = nullptr;
                    if (prompt) { if (pos >= 2045) dst = cpo + ((size_t)b * 3 + (pos - 2045)) * 1536 + ch; }
                    else if (pos >= 1) dst = cso + ((size_t)b * 3 + (pos - 1)) * 1536 + ch;
                    if (dst) { *(f32x4*)dst = (f32x4){pre[0], pre[1], pre[2], pre[3]}; *(f32x4*)(dst + 4) = (f32x4){pre[4], pre[5], pre[6], pre[7]}; }
                }
            }
            float s2 = 0.f;
#pragma unroll
            for (int e = 0; e < 8; ++e) { y[e] = siluf_(y[e]); s2 += y[e] * y[e]; }
            if (grp < 2) {
                s2 = red16(s2);
                const float r = rsqrtf(s2 + EPS) * (grp == 0 ? 0.08838834764831845f : 1.0f);
#pragma unroll
                for (int e = 0; e < 8; ++e) y[e] *= r;
            }
            bf16_t* dstb = (grp == 0 ? q16 : (grp == 1 ? k16 : v16)) + (size_t)t * 512 + c0;
            *(u32x4*)dstb = pack8(y);
        }
        if (lane < 4) {
            const float a = zl[(size_t)t * 8 + lane] + p.in[I_BDT][l * 4 + lane], bl = zl[(size_t)t * 8 + 4 + lane];
            const float sp = (a > 20.f) ? a : log1pf(__expf(a));
            gb[(size_t)t * 4 + lane] = -__expf(p.in[I_BAL][l * 4 + lane]) * sp;
            betab[(size_t)t * 4 + lane] = sigmoidf_(bl);
        }
    }
}

__device__ void phase_gmlp(const Params& p, int l, unsigned char* shm, const Ctx& cx) {
    const int tid = cx.tid, wid = tid >> 6, lane = tid & 63, fr = lane & 15, fq = lane >> 4;
    const bf16_t* ub = (const bf16_t*)(p.ws + WS_UB); const bf16_t* vnb = (const bf16_t*)(p.ws + WS_VNB); bf16_t* mix = (bf16_t*)(p.ws + WS_MIX);
    const float* aog = p.in[I_AOG] + l * 128;
    bf16_t* vs = (bf16_t*)shm;
    constexpr int VP = 136;
    for (int unit = cx.bid; unit < 512; unit += cx.nb) {
        const int b = unit >> 6, n = (unit >> 2) & 15, h = unit & 3, trow0 = b * 2048 + n * 128;
        const float* w = p.in[I_ASW] + ((size_t)l * 4 + h) * 128 * 128; const float* bias = p.in[I_ASB] + ((size_t)l * 4 + h) * 128;
#pragma unroll
        for (int ps = 0; ps < 4; ++ps) { const int r = tid & 127, c8 = (ps * 4 + (tid >> 7)) * 8;
            const u32x4 w = __builtin_nontemporal_load((const u32x4*)(vnb + (size_t)(trow0 + r) * 512 + h * 128 + c8));
            vs[(c8 + 0) * VP + r] = (bf16_t)(w.x & 0xffffu); vs[(c8 + 1) * VP + r] = (bf16_t)(w.x >> 16); vs[(c8 + 2) * VP + r] = (bf16_t)(w.y & 0xffffu); vs[(c8 + 3) * VP + r] = (bf16_t)(w.y >> 16);
            vs[(c8 + 4) * VP + r] = (bf16_t)(w.z & 0xffffu); vs[(c8 + 5) * VP + r] = (bf16_t)(w.z >> 16); vs[(c8 + 6) * VP + r] = (bf16_t)(w.w & 0xffffu); vs[(c8 + 7) * VP + r] = (bf16_t)(w.w >> 16); }
        __syncthreads();
        const int t0 = wid * 16, tt = t0 + fr;
        f32x4 acc[8];
#pragma unroll
        for (int nb = 0; nb < 8; ++nb) acc[nb] = (f32x4){0.f, 0.f, 0.f, 0.f};
        for (int k0 = 0; k0 < t0 + 16; k0 += 32) {
            const float* wp = w + (size_t)tt * 128 + k0 + fq * 8;
            const f32x4 wa = *(const f32x4*)wp, wb = *(const f32x4*)(wp + 4);
            float wf[8] = {wa[0], wa[1], wa[2], wa[3], wb[0], wb[1], wb[2], wb[3]};
#pragma unroll
            for (int e = 0; e < 8; ++e) if (k0 + fq * 8 + e > tt) wf[e] = 0.f;
            const u32x4 wpk = pack8(wf); const bf16x8 wfrag = *(const bf16x8*)&wpk;
#pragma unroll
            for (int nb = 0; nb < 8; ++nb) {
                const bf16x8 vf = *(const bf16x8*)(vs + (nb * 16 + fr) * VP + k0 + fq * 8);
                acc[nb] = __builtin_amdgcn_mfma_f32_16x16x32_bf16(vf, wfrag, acc[nb], 0, 0, 0);
            }
        }
        const int row = trow0 + tt; const float bs = bias[tt];
        float ss = 0.f;
#pragma unroll
        for (int nb = 0; nb < 8; ++nb) {
            const u32x2 uw = __builtin_nontemporal_load((const u32x2*)(ub + (size_t)row * 512 + h * 128 + nb * 16 + fq * 4));
            acc[nb][0] = (acc[nb][0] + bs) * bflo(uw.x); acc[nb][1] = (acc[nb][1] + bs) * bfhi(uw.x); acc[nb][2] = (acc[nb][2] + bs) * bflo(uw.y); acc[nb][3] = (acc[nb][3] + bs) * bfhi(uw.y);
            ss += acc[nb][0] * acc[nb][0] + acc[nb][1] * acc[nb][1] + acc[nb][2] * acc[nb][2] + acc[nb][3] * acc[nb][3];
        }
        ss += __shfl_xor(ss, 16); ss += __shfl_xor(ss, 32);
        const float r = rsqrtf(ss * (1.0f / 128.0f) + EPS);
#pragma unroll
        for (int nb = 0; nb < 8; ++nb) {
            const f32x4 gg = *(const f32x4*)(aog + nb * 16 + fq * 4);
            u32x2 ow; ow.x = cvt_pk_bf16(acc[nb][0] * r * gg[0], acc[nb][1] * r * gg[1]); ow.y = cvt_pk_bf16(acc[nb][2] * r * gg[2], acc[nb][3] * r * gg[3]);
            *(u32x2*)(mix + (size_t)row * DM + h * 128 + nb * 16 + fq * 4) = ow;
        }
        __syncthreads();
    }
    {
        const int c0 = lane * 8, hd = lane >> 4, cd = c0 & 127;
        for (int st = cx.bid * 8 + wid; st < TS; st += cx.nb * 8) {
            const int b = st >> 2, t = st & 3; const float* w = p.in[I_ASW] + ((size_t)l * 4 + hd) * 128 * 128 + t * 128;
            float mx[8]; const float bs = p.in[I_ASB][((size_t)l * 4 + hd) * 128 + t];
#pragma unroll
            for (int e = 0; e < 8; ++e) mx[e] = bs;
            for (int s = 0; s <= t; ++s) { float f[8]; unpack8(*(const u32x4*)(vnb + (size_t)(TP + b * 4 + s) * 512 + c0), f); const float ws_ = w[s];
#pragma unroll
                for (int e = 0; e < 8; ++e) mx[e] += ws_ * f[e]; }
            float uf[8]; unpack8(*(const u32x4*)(ub + (size_t)(TP + st) * 512 + c0), uf);
            float ss = 0.f;
#pragma unroll
            for (int e = 0; e < 8; ++e) { mx[e] *= uf[e]; ss += mx[e] * mx[e]; }
            ss = red16(ss);
            const float r = rsqrtf(ss * (1.0f / 128.0f) + EPS);
#pragma unroll
            for (int e = 0; e < 8; ++e) mx[e] = mx[e] * r * aog[cd + e];
            *(u32x4*)(mix + (size_t)(TP + st) * DM + c0) = pack8(mx);
        }
    }
}

__device__ void phase_delta_pre(const Params& p, unsigned char* shm, const Ctx& cx) {
    const int tid = cx.tid, half = tid >> 8, lt = tid & 255, lw = lt >> 6, lane = tid & 63, fr = lane & 15, fq = lane >> 4;
    const bf16_t* q16 = (const bf16_t*)(p.ws + WS_Q16); const bf16_t* k16 = (const bf16_t*)(p.ws + WS_K16); const bf16_t* v16 = (const bf16_t*)(p.ws + WS_V16);
    const float* gb = (const float*)(p.ws + WS_GB); const float* betab = (const float*)(p.ws + WS_BETA); float* btot = (float*)(p.ws + WS_BTOT);
    float* Lm = (float*)(shm + half * 32768);
    float* gam = (float*)(shm + half * 32768 + 16384);
    float* bet = gam + 64;
    for (int it = cx.bid; it < 512; it += cx.nb) {
        const int ck = it * 2 + half, b = ck >> 7, h = (ck >> 5) & 3, n = ck & 31, t0 = b * 2048 + n * 64;
        unsigned char* cb = p.ws + WS_CHUNK + (size_t)ck * CHUNK_BYTES;
        if (lt < 64) {
            float g = gb[(size_t)(t0 + lt) * 4 + h];
#pragma unroll
            for (int d = 1; d < 64; d <<= 1) { const float o = __shfl_up(g, d); if (lane >= d) g += o; }
            gam[lt] = g; bet[lt] = betab[(size_t)(t0 + lt) * 4 + h];
            if (lt == 63) btot[ck] = __expf(g);
        }
        __syncthreads();
        {
            const int rb = lw; bf16x8 ak[4], aq[4];
#pragma unroll
            for (int ks = 0; ks < 4; ++ks) { const size_t o = (size_t)(t0 + rb * 16 + fr) * 512 + h * 128 + ks * 32 + fq * 8; ak[ks] = *(const bf16x8*)(k16 + o); aq[ks] = *(const bf16x8*)(q16 + o); }
            bf16_t* qkd = (bf16_t*)(cb + CK_QKD);
            for (int sb = 0; sb < 4; ++sb) {
                f32x4 ckk = (f32x4){0.f, 0.f, 0.f, 0.f}, cqk = (f32x4){0.f, 0.f, 0.f, 0.f};
                if (sb <= rb) {
#pragma unroll
                    for (int ks = 0; ks < 4; ++ks) { const bf16x8 bk = *(const bf16x8*)(k16 + (size_t)(t0 + sb * 16 + fr) * 512 + h * 128 + ks * 32 + fq * 8);
                        ckk = __builtin_amdgcn_mfma_f32_16x16x32_bf16(ak[ks], bk, ckk, 0, 0, 0); cqk = __builtin_amdgcn_mfma_f32_16x16x32_bf16(aq[ks], bk, cqk, 0, 0, 0); }
                }
                const int s = sb * 16 + fr; const float gs = gam[s];
#pragma unroll
                for (int r = 0; r < 4; ++r) { const int c = rb * 16 + fq * 4 + r; const float dec = (s <= c) ? __expf(gam[c] - gs) : 0.f;
                    Lm[c * 64 + s] = (s < c) ? bet[c] * ckk[r] * dec : 0.f;
                    qkd[c * 64 + s] = (bf16_t)(cvt_pk_bf16(cqk[r] * dec, 0.f) & 0xffffu); }
            }
        }
        __syncthreads();
        {
            const int j = lt & 127; const bool isk = lt >= 128;
            const bf16_t* srcc = (isk ? k16 : v16) + (size_t)t0 * 512 + h * 128 + j;
            float x[64];
#pragma unroll
            for (int c = 0; c < 64; ++c) x[c] = bf2f(srcc[(size_t)c * 512]);
            if (isk) {
                const float gl = gam[63]; bf16_t* kendT = (bf16_t*)(cb + CK_KENDT) + j * 64;
#pragma unroll
                for (int c8 = 0; c8 < 64; c8 += 8) { float f[8];
#pragma unroll
                    for (int e = 0; e < 8; ++e) f[e] = x[c8 + e] * __expf(gl - gam[c8 + e]);
                    *(u32x4*)(kendT + c8) = pack8(f); }
#pragma unroll
                for (int c = 0; c < 64; ++c) x[c] *= bet[c] * __expf(gam[c]);
            } else {
                bf16_t* qb = (bf16_t*)(cb + CK_QB);
#pragma unroll
                for (int c = 0; c < 64; ++c) { const float qv = bf2f(q16[(size_t)(t0 + c) * 512 + h * 128 + j]) * __expf(gam[c]); qb[c * 128 + j] = (bf16_t)(cvt_pk_bf16(qv, 0.f) & 0xffffu); }
#pragma unroll
                for (int c = 0; c < 64; ++c) x[c] *= bet[c];
            }
#pragma unroll
            for (int c = 1; c < 64; ++c) {
                float a = x[c];
#pragma unroll
                for (int s4 = 0; s4 < c; s4 += 4) { const f32x4 lv = *(const f32x4*)(Lm + c * 64 + s4);
                    a -= lv[0] * x[s4]; if (s4 + 1 < c) a -= lv[1] * x[s4 + 1]; if (s4 + 2 < c) a -= lv[2] * x[s4 + 2]; if (s4 + 3 < c) a -= lv[3] * x[s4 + 3]; }
                x[c] = a;
            }
            if (isk) { bf16_t* nkb = (bf16_t*)(cb + CK_NKB);
#pragma unroll
                for (int c = 0; c < 64; ++c) nkb[c * 128 + j] = (bf16_t)(cvt_pk_bf16(-x[c], 0.f) & 0xffffu);
            } else { float* wT = (float*)(cb + CK_WT) + j * 64;
#pragma unroll
                for (int c = 0; c < 64; c += 4) *(f32x4*)(wT + c) = (f32x4){x[c], x[c + 1], x[c + 2], x[c + 3]};
            }
        }
        __syncthreads();
    }
}

__device__ void phase_delta_scan(const Params& p, int l, unsigned char* shm, const Ctx& cx) {
    const int tid = cx.tid, wid = tid >> 6, lane = tid & 63, fr = lane & 15, fq = lane >> 4;
    float* obuf = (float*)(p.ws + WS_OBUF); const float* btot = (const float*)(p.ws + WS_BTOT);
    {
        float* kq = (float*)shm;
        float* red1 = kq + 1024;
        float* red2 = red1 + 512;
        const bf16_t* q16 = (const bf16_t*)(p.ws + WS_Q16); const bf16_t* k16 = (const bf16_t*)(p.ws + WS_K16); const bf16_t* v16 = (const bf16_t*)(p.ws + WS_V16);
        const float* gb = (const float*)(p.ws + WS_GB); const float* betab = (const float*)(p.ws + WS_BETA);
        const int j = tid & 127, iq = tid >> 7;
        for (int sq = cx.bid; sq < 512; sq += cx.nb) {
            const int b = sq >> 2, h = sq & 3;
            const float* s0 = p.in[I_SS] + (((size_t)l * 128 + b) * 4 + h) * 16384; float* so = p.out + O_SS + (((size_t)l * 128 + b) * 4 + h) * 16384;
            float S[32];
#pragma unroll
            for (int ii = 0; ii < 32; ++ii) S[ii] = __builtin_nontemporal_load(s0 + (size_t)(iq * 32 + ii) * 128 + j);
            { const int t = tid >> 7, jj = tid & 127; const size_t o = (size_t)(TP + b * 4 + t) * 512 + h * 128 + jj; kq[t * 256 + jj] = bf2f(k16[o]); kq[t * 256 + 128 + jj] = bf2f(q16[o]); }
            __syncthreads();
            for (int t = 0; t < 4; ++t) {
                const int row = TP + b * 4 + t; const float a = __expf(gb[(size_t)row * 4 + h]), bt = betab[(size_t)row * 4 + h];
                const float* kv = kq + t * 256 + iq * 32; const float* qv = kq + t * 256 + 128 + iq * 32;
                float part = 0.f;
#pragma unroll
                for (int ii = 0; ii < 32; ++ii) part += kv[ii] * S[ii];
                red1[iq * 128 + j] = part;
                __syncthreads();
                const float kS = red1[j] + red1[128 + j] + red1[256 + j] + red1[384 + j];
                const float d = bt * (bf2f(v16[(size_t)row * 512 + h * 128 + j]) - a * kS);
                float part2 = 0.f;
#pragma unroll
                for (int ii = 0; ii < 32; ++ii) { S[ii] = a * S[ii] + kv[ii] * d; part2 += qv[ii] * S[ii]; }
                red2[iq * 128 + j] = part2;
                __syncthreads();
                if (iq == 0) obuf[(size_t)row * 512 + h * 128 + j] = red2[j] + red2[128 + j] + red2[256 + j] + red2[384 + j];
            }
#pragma unroll
            for (int ii = 0; ii < 32; ++ii) so[(size_t)(iq * 32 + ii) * 128 + j] = S[ii];
            __syncthreads();
        }
    }
    {
        bf16_t* ST = (bf16_t*)shm;
        bf16_t* uT = (bf16_t*)(shm + 16 * 136 * 2);
        constexpr int SP = 136, UP = 72;
        const int wv = __builtin_amdgcn_readfirstlane(wid); const bool roleU = wv < 4;
        const int cbk = (wv & 3) * 16, i0 = wv * 16;
        const bool do_cvt = l + 1 < NLAYER; int cit = do_cvt ? cx.bid * 8 + wv : CVT_ITEMS; const int cstride = cx.nb * 8;
        for (int item = cx.bid; item < 256; item += cx.nb) {
            const int bh = item >> 3, b = bh >> 2, h = bh & 3, j0 = (item & 7) * 16;
            f32x4 accS = (f32x4){0.f, 0.f, 0.f, 0.f};
            __syncthreads();
            for (int i = tid; i < 16 * SP / 2; i += 512) ((unsigned*)ST)[i] = 0u;
            bf16x8 a1[4], qk2[2], ke[2]; f32x4 w4; float bt;
            bf16x8 na1[4], nqk2[2], nke[2]; f32x4 nw4; float nbt;
#define SCAN_LOAD(ck_, A1, QK2, KE, W4, BT) do { const unsigned char* cb_ = p.ws + WS_CHUNK + (size_t)(ck_) * CHUNK_BYTES; \
                const bf16_t* A_ = (const bf16_t*)(cb_ + (roleU ? CK_NKB : CK_QB)) + (size_t)(cbk + fr) * 128 + fq * 8; \
                _Pragma("unroll") for (int ks = 0; ks < 4; ++ks) A1[ks] = *(const bf16x8*)(A_ + ks * 32); \
                const bf16_t* Q_ = (const bf16_t*)(cb_ + CK_QKD) + (size_t)(cbk + fr) * 64 + fq * 8; QK2[0] = *(const bf16x8*)Q_; QK2[1] = *(const bf16x8*)(Q_ + 32); \
                const bf16_t* K_ = (const bf16_t*)(cb_ + CK_KENDT) + (size_t)(i0 + fr) * 64 + fq * 8; KE[0] = *(const bf16x8*)K_; KE[1] = *(const bf16x8*)(K_ + 32); \
                W4 = *(const f32x4*)((const float*)(cb_ + CK_WT) + (size_t)(j0 + fr) * 64 + cbk + fq * 4); BT = btot[ck_]; } while (0)
            SCAN_LOAD(bh * 32, a1, qk2, ke, w4, bt);
            __syncthreads();
            for (int n = 0; n < 32; ++n) {
                if (n + 1 < 32) SCAN_LOAD(bh * 32 + n + 1, na1, nqk2, nke, nw4, nbt);
                CvtItem cv; const bool cvt_now = (n % 5 == 0) && cit < CVT_ITEMS;
                if (cvt_now) cvt_load(p, l + 1, cit, lane, cv);
                f32x4 acc = roleU ? w4 : (f32x4){0.f, 0.f, 0.f, 0.f};
#pragma unroll
                for (int ks = 0; ks < 4; ++ks) { const bf16x8 bb = *(const bf16x8*)(ST + fr * SP + ks * 32 + fq * 8); acc = __builtin_amdgcn_mfma_f32_16x16x32_bf16(a1[ks], bb, acc, 0, 0, 0); }
                if (roleU) { u32x2 w; w.x = cvt_pk_bf16(acc[0], acc[1]); w.y = cvt_pk_bf16(acc[2], acc[3]); *(u32x2*)(uT + fr * UP + cbk + fq * 4) = w; }
                __syncthreads();
                const bf16x8 u0 = *(const bf16x8*)(uT + fr * UP + fq * 8), u1 = *(const bf16x8*)(uT + fr * UP + 32 + fq * 8);
                if (!roleU) {
                    acc = __builtin_amdgcn_mfma_f32_16x16x32_bf16(qk2[0], u0, acc, 0, 0, 0);
                    acc = __builtin_amdgcn_mfma_f32_16x16x32_bf16(qk2[1], u1, acc, 0, 0, 0);
                    float* op = obuf + (size_t)(b * 2048 + n * 64 + cbk + fq * 4) * 512 + h * 128 + j0 + fr;
                    op[0] = acc[0]; op[512] = acc[1]; op[1024] = acc[2]; op[1536] = acc[3];
                }
                accS = accS * bt;
                accS = __builtin_amdgcn_mfma_f32_16x16x32_bf16(ke[0], u0, accS, 0, 0, 0);
                accS = __builtin_amdgcn_mfma_f32_16x16x32_bf16(ke[1], u1, accS, 0, 0, 0);
                { u32x2 w; w.x = cvt_pk_bf16(accS[0], accS[1]); w.y = cvt_pk_bf16(accS[2], accS[3]); *(u32x2*)(ST + fr * SP + i0 + fq * 4) = w; }
                __syncthreads();
#pragma unroll
                for (int ks = 0; ks < 4; ++ks) a1[ks] = na1[ks];
                qk2[0] = nqk2[0]; qk2[1] = nqk2[1]; ke[0] = nke[0]; ke[1] = nke[1]; w4 = nw4; bt = nbt;
                if (cvt_now) { cvt_store(cv); cit += cstride; }
            }
#undef SCAN_LOAD
            float* so = p.out + O_SP + (((size_t)l * 8 + b) * 4 + h) * 16384 + (size_t)(i0 + fq * 4) * 128 + j0 + fr;
            so[0] = accS[0]; so[128] = accS[1]; so[256] = accS[2]; so[384] = accS[3];
        }
        for (; cit < CVT_ITEMS; cit += cstride) { CvtItem c; cvt_load(p, l + 1, cit, lane, c); cvt_store(c); }
        if (do_cvt) convert_p(p, l + 1, cx);
    }
}

__device__ void phase_bout(const Params& p, int l, const Ctx& cx) {
    const int tid = cx.tid, wid = tid >> 6, lane = tid & 63, c0 = lane * 8, cd = c0 & 127;
    const float* obuf = (const float*)(p.ws + WS_OBUF); const bf16_t* z = (const bf16_t*)(p.ws + WS_F); bf16_t* mix = (bf16_t*)(p.ws + WS_MIX);
    const float* bog = p.in[I_BOG] + l * 128;
    float gv[8];
#pragma unroll
    for (int e = 0; e < 8; ++e) gv[e] = bog[cd + e];
    const int stride = cx.nb * 8; int t = cx.bid * 8 + wid; const __amdgpu_buffer_rsrc_t mixr = wt_rsrc(mix);
    if (t < T) {
        f32x4 a0 = __builtin_nontemporal_load((const f32x4*)(obuf + (size_t)t * 512 + c0)), b0 = __builtin_nontemporal_load((const f32x4*)(obuf + (size_t)t * 512 + c0 + 4)); u32x4 g0 = __builtin_nontemporal_load((const u32x4*)(z + (size_t)t * NIN + ZG + c0));
        for (;;) {
            const int tn = t + stride; const bool hn = tn < T; const int tl = hn ? tn : t;
            const f32x4 a1 = __builtin_nontemporal_load((const f32x4*)(obuf + (size_t)tl * 512 + c0)), b1 = __builtin_nontemporal_load((const f32x4*)(obuf + (size_t)tl * 512 + c0 + 4)); const u32x4 g1 = __builtin_nontemporal_load((const u32x4*)(z + (size_t)tl * NIN + ZG + c0));
            float o[8] = {a0[0], a0[1], a0[2], a0[3], b0[0], b0[1], b0[2], b0[3]}, gt[8];
            unpack8(g0, gt);
            float ss = 0.f;
#pragma unroll
            for (int e = 0; e < 8; ++e) ss += o[e] * o[e];
            ss = red16(ss);
            const float r = rsqrtf(ss * (1.0f / 128.0f) + EPS);
#pragma unroll
            for (int e = 0; e < 8; ++e) o[e] = o[e] * r * gv[e] * siluf_(gt[e]);
            st16_wt(mixr, ((size_t)t * DM + 512 + c0) * 2, pack8(o));
            if (!hn) break;
            a0 = a1; b0 = b1; g0 = g1; t = tn;
        }
    }
}

#if MK_TIME == 14
#define MINI_T0 __syncthreads(); const unsigned long long mt0 = __builtin_amdgcn_s_memrealtime();
#define MINI_T1 __syncthreads(); if (cx.bid == 0 && cx.tid == 0) ((unsigned long long*)(p.ws + WS_STAMP))[200] += __builtin_amdgcn_s_memrealtime() - mt0;
#else
#define MINI_T0
#define MINI_T1
#endif
__device__ __forceinline__ void run_phase(const Params& p, int ph, unsigned char* shm, const Ctx& cx, const int rep) {
    if (ph == NPHASES - 1) { phase_norm(p, p.in[I_FN], false, true, cx); return; }
    const int l = ph < NPH_L ? 0 : 1 + (ph - NPH_L) / (NPH_L - 1), s = ph < NPH_L ? ph : 1 + (ph - NPH_L) % (NPH_L - 1);
    PG8_LAS unsigned char* lds = (PG8_LAS unsigned char*)shm;
    const bf16_t* wt = (const bf16_t*)(p.ws + WS_WT) + (size_t)(l & 1) * W_TOTAL; const bf16_t* pbl = (const bf16_t*)(p.ws + WS_PB) + (size_t)(l & 1) * T * 256;
    const bf16_t* xb = (const bf16_t*)(p.ws + WS_XN); bf16_t* hb = (bf16_t*)(p.ws + WS_F);
    u64* rss = (u64*)(p.ws + WS_ROWSS) + (size_t)l * 4 * T;
    const float rsc = rep ? 0.f : 1.f;
    switch (s) {
    case 0: phase_convert(p, l, shm, cx); if (l == 0) phase_norm(p, nullptr, true, false, cx); break;
    case 1: { EpiSwiGLU E; E.H = hb; E.RS = rss; run_gemm(lds, l == 0 ? xb : (const bf16_t*)(p.ws + WS_MIX), wt + W_F1IN, 5632, 1024, E, cx); } break;
    case 2: { EpiResidT<false> E; E.XS = l == 0 ? xb : (const bf16_t*)(p.ws + WS_MIX); E.XD = (bf16_t*)(p.ws + WS_XN); E.RSO = rep ? nullptr : rss + T; E.scale = 0.5f * rsc; E.PP = nullptr; E.RS = nullptr; run_gemm(lds, hb, wt + W_F1OUT, 1024, 2816, E, cx, TP); MINI_T0 mini_gemm_sample<0>(hb, wt + W_F1OUT, 2816, E, cx, shm); MINI_T1 } break;
    case 3: { EpiZ E; E.Z = hb; E.ZL = (float*)(p.ws + WS_ZL); E.RS = rss + T; run_gemm(lds, xb, wt + W_IN, NIN, 1024, E, cx); } break;
    case 4: phase_postin(p, l, cx); break;
    case 5: phase_gmlp(p, l, shm, cx); __syncthreads(); phase_delta_pre(p, shm, cx); break;
    case 6: phase_delta_scan(p, l, shm, cx); break;
    case 7: { phase_bout(p, l, cx); __syncthreads();
              EpiStoreBf16 E; E.C = (bf16_t*)(p.ws + WS_PP); run_gemm(lds, pbl, wt + W_PLE, 1024, 256, E, cx, TP);
              EpiResidT<false> M; M.XS = nullptr; M.XD = (bf16_t*)(p.ws + WS_PP); M.RSO = nullptr; M.scale = 0.f; M.PP = nullptr; M.RS = nullptr; MINI_T0 mini_gemm_sample<2>(pbl, wt + W_PLE, 256, M, cx, shm); MINI_T1 } break;
    case 8: { EpiResidT<false> E; E.XS = xb; E.XD = (bf16_t*)(p.ws + WS_XN); E.RSO = rep ? nullptr : rss + 2 * T; E.scale = rsc; E.PP = nullptr; E.RS = nullptr; run_gemm(lds, (const bf16_t*)(p.ws + WS_MIX), wt + W_OUT, 1024, 1024, E, cx, TP); MINI_T0 mini_gemm_sample<0>((const bf16_t*)(p.ws + WS_MIX), wt + W_OUT, 1024, E, cx, shm); MINI_T1 } break;
    case 9: { EpiSwiGLU E; E.H = hb; E.RS = rss + 2 * T; run_gemm(lds, xb, wt + W_F2IN, 5632, 1024, E, cx); } break;
    case 10: { EpiResidT<false> E; E.XS = xb; E.XD = (bf16_t*)(p.ws + WS_XN); E.RSO = rep ? nullptr : rss + 3 * T; E.scale = 0.5f * rsc; E.PP = nullptr; E.RS = nullptr; run_gemm(lds, hb, wt + W_F2OUT, 1024, 2816, E, cx, TP); MINI_T0 mini_gemm_sample<0>(hb, wt + W_F2OUT, 2816, E, cx, shm); MINI_T1 } break;
    default: { EpiResidT<true> E; E.XS = xb; E.XD = (bf16_t*)(p.ws + WS_MIX); E.RSO = (l == NLAYER - 1 || rep) ? nullptr : rss + 4 * T; E.scale = 1.f; E.PP = (const bf16_t*)(p.ws + WS_PP); E.RS = rss + 3 * T;
                 run_gemm(lds, xb, wt + W_GATE, 1024, 1024, E, cx, TP); MINI_T0 mini_gemm_sample<1>(xb, wt + W_GATE, 1024, E, cx, shm); MINI_T1 } break;
    }
}

__global__ __launch_bounds__(512, 2) void mk_fwd(Params p) {
    extern __shared__ __attribute__((aligned(16))) unsigned char shm[];
    cg::grid_group grid = cg::this_grid();
    const int lo = p.ph_lo, hi = p.ph_hi;
    if (hi > 100000) grid.sync();
    volatile LAS unsigned* bst = (volatile LAS unsigned*)(shm + pg8::STAGE_BYTES);
    if (threadIdx.x < 4) bst[threadIdx.x] = 0u;
    __syncthreads();
    const XcdBarrier gbar = xcd_barrier_post((unsigned*)(p.ws + WS_BAR), bst);
#ifndef MK_REP
#define MK_REP 0
#endif
#if MK_TIME
    if (blockIdx.x == 0 && threadIdx.x == 0) ((unsigned long long*)(p.ws + WS_STAMP))[200] = 0ull;
#endif
    for (int ph = lo; ph < hi; ++ph) {
#if MK_TIME
        __syncthreads(); if (blockIdx.x == 0 && threadIdx.x == 0 && ph > lo) ((unsigned long long*)(p.ws + WS_STAMP))[2 * (ph - 1) + 1] = __builtin_amdgcn_s_memrealtime();
#endif
        if (ph > lo) xcd_barrier(gbar);
#if MK_TIME
        if (blockIdx.x == 0 && threadIdx.x == 0) ((unsigned long long*)(p.ws + WS_STAMP))[2 * ph] = __builtin_amdgcn_s_memrealtime();
#endif
        const int nrep = 1;
        for (int rep = 0; rep < nrep; ++rep) {
            if (rep) __syncthreads();
            const __attribute__((address_space(4))) Params* kp = (const __attribute__((address_space(4))) Params*)__builtin_amdgcn_kernarg_segment_ptr();
            asm volatile("" : "+s"(kp));
            Ctx cx; cx.tid = threadIdx.x; cx.bid = blockIdx.x; cx.nb = gridDim.x;
            asm volatile("" : "+v"(cx.tid)); asm volatile("" : "+s"(cx.bid), "+s"(cx.nb));
            run_phase(*(const Params*)kp, ph, shm, cx, rep);
        }
    }
}

#ifndef MK_DIAG
#define MK_DIAG 0
#endif
#if MK_DIAG
__device__ __forceinline__ unsigned hsh(unsigned x) { x ^= x >> 16; x *= 0x7feb352du; x ^= x >> 15; x *= 0x846ca68bu; x ^= x >> 16; return x; }
__device__ __forceinline__ bool bad(float got, float ref, float rel, float ab) { return !(fabsf(got - ref) <= rel * fabsf(ref) + ab); }
__global__ void diag_kernel(Params p, int ph) {
    unsigned* flags = (unsigned*)(p.ws + WS_END);
    const int i = threadIdx.x; const int l = 0;
    const bf16_t* wt = (const bf16_t*)(p.ws + WS_WT); const bf16_t* xn = (const bf16_t*)(p.ws + WS_XN); const bf16_t* F = (const bf16_t*)(p.ws + WS_F); const float* xres = (const float*)(p.ws + WS_XRES);
    if (ph == -1) { if (i == 0) flags[0] = 0u; return; }
    if (ph == 100) { if (i == 0) p.out[0] = exp2f((float)(flags[0] & 127u)); return; }
    bool f = false; int bit = -1;
    const bf16_t* q16 = (const bf16_t*)(p.ws + WS_Q16); const bf16_t* k16 = (const bf16_t*)(p.ws + WS_K16); const bf16_t* v16 = (const bf16_t*)(p.ws + WS_V16);
    const float* gb = (const float*)(p.ws + WS_GB); const float* betab = (const float*)(p.ws + WS_BETA); const float* obuf = (const float*)(p.ws + WS_OBUF);
    if (ph == 0) { bit = 6;
        { const int n = hsh(i) % 5632, k = hsh(i + 1000) % 1024; const int sc = src_col(1, n & ~3) + (n & 3); f |= bad(bf2f(wt[W_F2IN + (size_t)n * 1024 + k]), p.in[I_WF2I][(size_t)k * 5632 + sc], 0.01f, 1e-6f); }
        { const int n = hsh(i + 2) % 1024, k = hsh(i + 1002) % 2816; f |= bad(bf2f(wt[W_F2OUT + (size_t)n * 2816 + k]), p.in[I_WF2O][(size_t)k * 1024 + n], 0.01f, 1e-6f); }
        { const int n = hsh(i + 3) % 1024, k = hsh(i + 1003) % 1024; f |= bad(bf2f(wt[W_OUT + (size_t)n * 1024 + k]), p.in[I_WOUT][(size_t)k * 1024 + n], 0.01f, 1e-6f); }
        { const int n = hsh(i + 4) % 1024, k = hsh(i + 1004) % 1024; f |= bad(bf2f(wt[W_GATE + (size_t)n * 1024 + k]), p.in[I_WPG][(size_t)k * 1024 + n], 0.01f, 1e-6f); }
    }
    if (ph == 6) {
        const int ck = hsh(i / 64 + 900) % 1024, b = ck >> 7, h = (ck >> 5) & 3, n = ck & 31, t0 = b * 2048 + n * 64;
        const unsigned char* cb = p.ws + WS_CHUNK + (size_t)ck * CHUNK_BYTES;
        const int c = hsh(i + 31) % 64, j = hsh(i + 32) % 128, s_ = hsh(i + 33) % 64;
        float gamc = 0.f, gams = 0.f, gl = 0.f, run = 0.f;
        for (int t = 0; t < 64; ++t) { run += gb[(size_t)(t0 + t) * 4 + h]; if (t == c) gamc = run; if (t == s_) gams = run; if (t == 63) gl = run; }
        const float bc = betab[(size_t)(t0 + c) * 4 + h];
        float lw_ = 0.f, lk_ = 0.f, g2 = 0.f;
        const float* wT = (const float*)(cb + CK_WT) + (size_t)j * 64; const bf16_t* nkb = (const bf16_t*)(cb + CK_NKB);
        for (int s = 0; s < c; ++s) { g2 += gb[(size_t)(t0 + s) * 4 + h]; float kk = 0.f; for (int e = 0; e < 128; ++e) kk += bf2f(k16[(size_t)(t0 + c) * 512 + h * 128 + e]) * bf2f(k16[(size_t)(t0 + s) * 512 + h * 128 + e]);
            const float L = bc * kk * expf(gamc - g2); lw_ += L * wT[s]; lk_ += L * (-bf2f(nkb[s * 128 + j])); }
        const float rw = bc * bf2f(v16[(size_t)(t0 + c) * 512 + h * 128 + j]), rk = bc * expf(gamc) * bf2f(k16[(size_t)(t0 + c) * 512 + h * 128 + j]);
        if (bad(lw_ + wT[c], rw, 0.02f, 0.003f)) atomicOr(flags, 1u);
        if (bad(lk_ - bf2f(nkb[c * 128 + j]), rk, 0.03f, 0.002f)) atomicOr(flags, 2u);
        { float qk = 0.f; for (int e = 0; e < 128; ++e) qk += bf2f(q16[(size_t)(t0 + c) * 512 + h * 128 + e]) * bf2f(k16[(size_t)(t0 + s_) * 512 + h * 128 + e]);
          const float ref = (s_ <= c) ? qk * expf(gamc - gams) : 0.f; if (bad(bf2f(((const bf16_t*)(cb + CK_QKD))[c * 64 + s_]), ref, 0.03f, 0.0005f)) atomicOr(flags, 4u); }
        { bool g = false; g |= bad(bf2f(((const bf16_t*)(cb + CK_QB))[c * 128 + j]), bf2f(q16[(size_t)(t0 + c) * 512 + h * 128 + j]) * expf(gamc), 0.02f, 1e-5f);
          g |= bad(bf2f(((const bf16_t*)(cb + CK_KENDT))[j * 64 + c]), bf2f(k16[(size_t)(t0 + c) * 512 + h * 128 + j]) * expf(gl - gamc), 0.02f, 1e-5f);
          g |= bad(((const float*)(p.ws + WS_BTOT))[ck], expf(gl), 0.01f, 1e-30f); if (g) atomicOr(flags, 8u); }
    }
    if (ph == 7) {
        const int wv = i >> 6, lane = i & 63;
        {
            const int b = (wv * 3 + 1) & 7, h = wv & 3, j = (wv * 37 + 5) & 127;
            float s0 = 0.f, s1 = 0.f, maxerr = 0.f, maxref = 0.f; bool f4 = false;
            for (int t = 0; t < 2048; ++t) { const size_t r = (size_t)(b * 2048 + t); const float k0 = bf2f(k16[r * 512 + h * 128 + lane]), k1 = bf2f(k16[r * 512 + h * 128 + 64 + lane]);
                const float q0 = bf2f(q16[r * 512 + h * 128 + lane]), q1 = bf2f(q16[r * 512 + h * 128 + 64 + lane]); const float a = expf(gb[r * 4 + h]), bt = betab[r * 4 + h];
                const float kS = red64(k0 * s0 + k1 * s1); const float d = bt * (bf2f(v16[r * 512 + h * 128 + j]) - a * kS); s0 = a * s0 + k0 * d; s1 = a * s1 + k1 * d;
                const float o = red64(q0 * s0 + q1 * s1); maxerr = fmaxf(maxerr, fabsf(o - obuf[r * 512 + h * 128 + j])); maxref = fmaxf(maxref, fabsf(o));
                if (t == 63) f4 = !(maxerr <= 0.05f * maxref + 1e-4f); }
            if (f4) atomicOr(flags, 16u);
            if (!(maxerr <= 0.05f * maxref + 1e-4f)) atomicOr(flags, 32u);
        }
    }
    if (bit >= 0 && f) atomicOr(flags, 1u << bit);
}
#endif
#ifndef MK_ONE_LAUNCH
#define MK_ONE_LAUNCH 1
#endif
extern "C" void kernel_launch(void* const* d_in, const int* in_sizes, int n_in, void* d_out, int out_size, void* d_ws, size_t ws_size, hipStream_t stream) {
    static int grid = 0;
    if (grid == 0) {
        if (n_in != 27 || (size_t)out_size != O_END || ws_size < WS_END + 256) { fprintf(stderr, "kernel_launch: unexpected shapes (n_in %d out %d ws %zu need %zu)\n", n_in, out_size, ws_size, (size_t)WS_END); grid = -1; return; }
        int dev = 0, cus = 0, per_cu = 0;
        hipGetDevice(&dev); hipDeviceGetAttribute(&cus, hipDeviceAttributeMultiprocessorCount, dev);
        if (hipFuncSetAttribute((const void*)mk_fwd, hipFuncAttributeMaxDynamicSharedMemorySize, LDS_BYTES) != hipSuccess) { fprintf(stderr, "kernel_launch: hipFuncSetAttribute failed\n"); grid = -1; return; }
        if (hipOccupancyMaxActiveBlocksPerMultiprocessor(&per_cu, (const void*)mk_fwd, 512, LDS_BYTES) != hipSuccess || per_cu < 1) { fprintf(stderr, "kernel_launch: occupancy query says %d\n", per_cu); per_cu = 1; }
        (void)hipGetLastError();
        grid = cus * 1;
    }
    if (grid < 0) return;
    Params p{};
    for (int i = 0; i < 27; ++i) p.in[i] = (const float*)d_in[i];
    p.out = (float*)d_out; p.ws = (unsigned char*)d_ws;
    if (hipMemsetAsync((char*)d_ws + WS_BAR, 0, XCD_BAR_WORDS * 4, stream) != hipSuccess) { fprintf(stderr, "kernel_launch: memset of the barrier words failed\n"); return; }
#if MK_ONE_LAUNCH
    p.ph_lo = 0; p.ph_hi = NPHASES;
    void* args[] = {&p};
    hipError_t e = hipLaunchCooperativeKernel((const void*)mk_fwd, dim3(grid), dim3(512), args, LDS_BYTES, stream);
    if (e != hipSuccess) fprintf(stderr, "cooperative launch failed: %s (grid %d)\n", hipGetErrorString(e), grid);
#else
#if MK_DIAG
    hipLaunchKernelGGL(diag_kernel, dim3(1), dim3(256), 0, stream, p, -1);
#endif
    for (int ph = 0; ph < NPHASES; ++ph) { p.ph_lo = ph; p.ph_hi = ph + 1; hipLaunchKernelGGL(mk_fwd, dim3(grid), dim3(512), LDS_BYTES, stream, p);
#if MK_DIAG
        p.ph_lo = 0; p.ph_hi = 0; if (ph < 16) hipLaunchKernelGGL(diag_kernel, dim3(1), dim3(256), 0, stream, p, ph);
#endif
    }
#if MK_DIAG
    p.ph_lo = 0; p.ph_hi = 0; hipLaunchKernelGGL(diag_kernel, dim3(1), dim3(256), 0, stream, p, 100);
#endif
#endif
}
```
